# Optimizing an MI355X kernel written in HIP

```python
import jax, jax.numpy as jnp
from jax import lax
import numpy as np

D_MODEL = 1024
BATCH = 16
SEQ = 256
DEPTH = 4
DEC_BATCH = 8
DEC_SEQ = 1024
PAST_LEN = 512

GRID_W = 64
N_REC = (DEPTH + 1) // 2
N_ATT = DEPTH // 2
POOL_WIDTH = D_MODEL // 2
POOL_WINDOWS = (2, 4, 8, 16)
POOL_GROUPS = len(POOL_WINDOWS)
POOL_GROUP_DIM = POOL_WIDTH // POOL_GROUPS
REC_WIDTH = D_MODEL // 2
REC_HEAD_DIM = 128
REC_HEADS = REC_WIDTH // REC_HEAD_DIM
CHUNK = 16
REC_IN_WIDTH = 2 * POOL_WIDTH + 5 * REC_WIDTH
REC_OUT_IN = POOL_WIDTH + REC_WIDTH
ATT_HEAD_DIM = 128
ATT_HEADS = D_MODEL // ATT_HEAD_DIM
ATT_KV_HEADS = 2
ATT_WIDTH = ATT_HEADS * ATT_HEAD_DIM
KV_WIDTH = ATT_KV_HEADS * ATT_HEAD_DIM
ATT_IN_WIDTH = 2 * ATT_WIDTH + 2 * KV_WIDTH
AXIS_DIM = ATT_HEAD_DIM // 2
Q_BLOCK = 128
ROPE_THETA = 10000.0
EPS = 1e-6
F_MIN = 1e-6

kernel_name = "hybrid_pool_hgrn2_gqa_prefix_diffusion_step"


def rmsnorm(x, g):
    xf = x.astype(jnp.float32)
    y = xf * lax.rsqrt(jnp.mean(xf * xf, axis=-1, keepdims=True) + EPS)
    return (y * g.astype(jnp.float32)).astype(x.dtype)


def modulation(cvec, w, b):
    m = jax.nn.silu(cvec) @ w + b
    shift, scale, gate = jnp.split(m, 3, axis=-1)
    return shift[:, None, :], scale[:, None, :], gate[:, None, :]


def axial_rope(n_tokens):
    rows = n_tokens // GRID_W
    t = jnp.arange(rows * GRID_W)
    row = (t // GRID_W).astype(jnp.float32)
    col = (t % GRID_W).astype(jnp.float32)
    inv = ROPE_THETA ** (-jnp.arange(0, AXIS_DIM, 2, dtype=jnp.float32) / AXIS_DIM)
    ang = jnp.concatenate([row[:, None] * inv[None, :], col[:, None] * inv[None, :]], axis=-1)
    return jnp.cos(ang)[None, :, None, :], jnp.sin(ang)[None, :, None, :]


def apply_rope(x, cos, sin):
    xf = x.astype(jnp.float32)
    x1, x2 = xf[..., 0::2], xf[..., 1::2]
    y = jnp.stack([x1 * cos - x2 * sin, x1 * sin + x2 * cos], axis=-1).reshape(x.shape)
    return y.astype(x.dtype)


def pool_mixer(u, w, scale):
    B, L, _ = u.shape
    uf = u.astype(jnp.float32)
    cs = jnp.concatenate([jnp.zeros((B, 1, POOL_WIDTH), jnp.float32), jnp.cumsum(uf, axis=1)], axis=1)
    t = jnp.arange(L)
    outs = []
    for g, win in enumerate(POOL_WINDOWS):
        sl = slice(g * POOL_GROUP_DIM, (g + 1) * POOL_GROUP_DIM)
        lo = jnp.clip(t - win // 2, 0, L)
        hi = jnp.clip(t + win // 2, 0, L)
        cnt = (hi - lo).astype(jnp.float32)
        mean = (cs[:, hi, sl] - cs[:, lo, sl]) / cnt[None, :, None]
        outs.append(mean - uf[..., sl])
    d = jnp.stack(outs, axis=2)
    y = jnp.einsum('blgc,gcd->blgd', d, w.astype(jnp.float32)).reshape(B, L, POOL_WIDTH)
    return (y * scale.astype(jnp.float32)).astype(u.dtype)


def hgrn2_scan(q, k, v, log_f, s0):
    B, L, H, DK = q.shape
    DV = v.shape[-1]
    n = L // CHUNK

    def chunks(a):
        return a.reshape(B, n, CHUNK, H, a.shape[-1]).transpose(1, 0, 3, 2, 4)

    qc, kc, vc, gc = chunks(q), chunks(k), chunks(v), chunks(log_f)
    b = jnp.cumsum(gc, axis=3)
    mask = jnp.tril(jnp.ones((CHUNK, CHUNK), dtype=bool))[:, :, None]
    diff = b[..., :, None, :] - b[..., None, :, :]
    decay = jnp.where(mask, jnp.exp(jnp.where(mask, diff, 0.0)), 0.0)
    a_intra = jnp.einsum('nbhtd,nbhsd,nbhtsd->nbhts', qc, kc, decay)
    o_intra = jnp.einsum('nbhts,nbhsv->nbhtv', a_intra, vc)
    q_in = qc * jnp.exp(b)
    k_out = kc * jnp.exp(b[..., -1:, :] - b)
    a_last = jnp.exp(b[..., -1, :])

    def step(S, inp):
        qi, ko, vi, al = inp
        o = jnp.einsum('bhtd,bhdv->bhtv', qi, S)
        S = al[..., None] * S + jnp.einsum('bhsd,bhsv->bhdv', ko, vi)
        return S, o

    s_final, o_inter = lax.scan(step, s0.astype(jnp.float32), (q_in, k_out, vc, a_last))
    o = (o_intra + o_inter).transpose(1, 0, 3, 2, 4).reshape(B, L, H, DV)
    return o, s_final


def rec_mixer(h, s0, w_in, lb, head_norm, p_w, p_scale, w_out):
    B, L, _ = h.shape
    P, R = POOL_WIDTH, REC_WIDTH
    z = h @ w_in
    u_pool, g_pool, q, f_fw, f_bw, i_v, g_rec = jnp.split(
        z, [P, 2 * P, 2 * P + R, 2 * P + 2 * R, 2 * P + 3 * R, 2 * P + 4 * R], axis=-1)
    y_pool = pool_mixer(u_pool, p_w, p_scale) * jax.nn.silu(g_pool)

    qf = jax.nn.silu(q.astype(jnp.float32)).reshape(B, L, REC_HEADS, REC_HEAD_DIM)
    vf = i_v.astype(jnp.float32).reshape(B, L, REC_HEADS, REC_HEAD_DIM)
    lbf = lb.astype(jnp.float32)

    def forget(zf, lower):
        f = lower + (1.0 - lower) * jax.nn.sigmoid(zf.astype(jnp.float32))
        f = jnp.clip(f, F_MIN, 1.0).reshape(B, L, REC_HEADS, REC_HEAD_DIM)
        return jnp.log(f), 1.0 - f

    lf_f, k_f = forget(f_fw, lbf[0])
    lf_b, k_b = forget(f_bw, lbf[1])
    o_f, s_f = hgrn2_scan(qf, k_f, vf, lf_f, s0[:, 0])
    flip = lambda a: jnp.flip(a, axis=1)
    o_b, s_b = hgrn2_scan(flip(qf), flip(k_b), flip(vf), flip(lf_b), s0[:, 1])
    o = o_f + flip(o_b)
    o = rmsnorm(o, head_norm).reshape(B, L, REC_WIDTH).astype(h.dtype) * jax.nn.silu(g_rec)
    y = jnp.concatenate([y_pool, o], axis=-1) @ w_out
    return y, jnp.stack([s_f, s_b], axis=1)


def att_project(h, w_in, q_norm, k_norm):
    B, L, _ = h.shape
    z = h @ w_in
    q, k, v, g = jnp.split(z, [ATT_WIDTH, ATT_WIDTH + KV_WIDTH, ATT_WIDTH + 2 * KV_WIDTH], axis=-1)
    q = rmsnorm(q.reshape(B, L, ATT_HEADS, ATT_HEAD_DIM), q_norm)
    k = rmsnorm(k.reshape(B, L, ATT_KV_HEADS, ATT_HEAD_DIM), k_norm)
    v = v.reshape(B, L, ATT_KV_HEADS, ATT_HEAD_DIM)
    return q, k, v, g


def attention(q, k, v):
    B, Lq, H, D = q.shape
    rep = H // ATT_KV_HEADS
    scale = D ** -0.5
    qb = q.reshape(B, Lq // Q_BLOCK, Q_BLOCK, ATT_KV_HEADS, rep, D).transpose(1, 0, 2, 3, 4, 5)
    kf = k.astype(jnp.float32)
    vf = v.astype(jnp.float32)

    def one_block(qblk):
        s = jnp.einsum('bqgrd,bkgd->bgrqk', qblk.astype(jnp.float32), kf) * scale
        p = jax.nn.softmax(s, axis=-1)
        return jnp.einsum('bgrqk,bkgd->bqgrd', p, vf)

    o = lax.map(one_block, qb)
    return o.transpose(1, 0, 2, 3, 4, 5).reshape(B, Lq, H * D).astype(q.dtype)


def setup_inputs(seed: int = 0) -> dict:
    key = jax.random.key(seed)
    ks = jax.random.split(key, 21)
    f32 = jnp.float32

    def nrm(k, shape, scale):
        return jax.random.normal(k, shape, f32) * scale

    D = D_MODEL
    return {
        "x_prompt": nrm(ks[0], (BATCH, SEQ, D), 1.0),
        "x_sample": nrm(ks[1], (DEC_BATCH, DEC_SEQ, D), 1.0),
        "c": nrm(ks[2], (DEC_BATCH, D), 1.0),
        "state_hgrn": nrm(ks[3], (DEC_BATCH, N_REC, 2, REC_HEADS, REC_HEAD_DIM, REC_HEAD_DIM), 0.5),
        "cache_k": nrm(ks[4], (DEC_BATCH, N_ATT, PAST_LEN, ATT_KV_HEADS, ATT_HEAD_DIM), 1.0),
        "cache_v": nrm(ks[5], (DEC_BATCH, N_ATT, PAST_LEN, ATT_KV_HEADS, ATT_HEAD_DIM), 1.0),
        "c_ctx": nrm(ks[6], (D,), 1.0),
        "ada_w": nrm(ks[7], (DEPTH, D, 3 * D), 0.5 * D ** -0.5),
        "ada_b": nrm(ks[8], (DEPTH, 3 * D), 0.02),
        "norm_pre": 1.0 + nrm(ks[9], (DEPTH, D), 0.05),
        "norm_post": 1.0 + nrm(ks[10], (DEPTH, D), 0.05),
        "rec_w_in": nrm(ks[11], (N_REC, D, REC_IN_WIDTH), D ** -0.5),
        "rec_lb_logits": nrm(ks[12], (N_REC, 2, REC_WIDTH), 0.1),
        "rec_head_norm": 1.0 + nrm(ks[13], (N_REC, REC_HEAD_DIM), 0.05),
        "pool_w": nrm(ks[14], (N_REC, POOL_GROUPS, POOL_GROUP_DIM, POOL_GROUP_DIM), POOL_GROUP_DIM ** -0.5),
        "pool_scale": 1.0 + nrm(ks[15], (N_REC, POOL_WIDTH), 0.05),
        "rec_w_out": nrm(ks[16], (N_REC, REC_OUT_IN, D), REC_OUT_IN ** -0.5),
        "att_w_in": nrm(ks[17], (N_ATT, D, ATT_IN_WIDTH), D ** -0.5),
        "att_q_norm": 1.0 + nrm(ks[18], (N_ATT, ATT_HEAD_DIM), 0.05),
        "att_k_norm": 1.0 + nrm(ks[19], (N_ATT, ATT_HEAD_DIM), 0.05),
        "att_w_out": nrm(ks[20], (N_ATT, ATT_WIDTH, D), ATT_WIDTH ** -0.5),
    }


def reference(x_prompt, x_sample, c, state_hgrn, cache_k, cache_v, c_ctx, ada_w, ada_b,
              norm_pre, norm_post, rec_w_in, rec_lb_logits, rec_head_norm, pool_w, pool_scale,
              rec_w_out, att_w_in, att_q_norm, att_k_norm, att_w_out):
    lb_p = jax.nn.softmax(rec_lb_logits.astype(jnp.float32), axis=0)
    lower_bounds = jnp.clip(jnp.cumsum(lb_p, axis=0) - lb_p[0], 0.0, 1.0)
    cos, sin = axial_rope(x_sample.shape[1])

    xc, xl = x_prompt, x_sample
    new_states, new_k, new_v = [], [], []
    for i in range(DEPTH):
        j = i // 2
        sh_c, sc_c, gt_c = modulation(c_ctx[None, :], ada_w[i], ada_b[i])
        sh_l, sc_l, gt_l = modulation(c, ada_w[i], ada_b[i])
        hc = rmsnorm(xc, norm_pre[i]) * (1.0 + sc_c) + sh_c
        hl = rmsnorm(xl, norm_pre[i]) * (1.0 + sc_l) + sh_l
        if i % 2 == 0:
            s_zero = jnp.zeros((hc.shape[0], 2, REC_HEADS, REC_HEAD_DIM, REC_HEAD_DIM), jnp.float32)
            oc, s_ctx = rec_mixer(hc, s_zero, rec_w_in[j], lower_bounds[j], rec_head_norm[j],
                                  pool_w[j], pool_scale[j], rec_w_out[j])
            new_states.append(s_ctx.astype(x_prompt.dtype))
            ol, _ = rec_mixer(hl, state_hgrn[:, j], rec_w_in[j], lower_bounds[j], rec_head_norm[j],
                              pool_w[j], pool_scale[j], rec_w_out[j])
        else:
            qc_, kc_, vc_, gc_ = att_project(hc, att_w_in[j], att_q_norm[j], att_k_norm[j])
            oc = (attention(qc_, kc_, vc_) * jax.nn.silu(gc_)) @ att_w_out[j]
            new_k.append(kc_)
            new_v.append(vc_)
            ql, kl, vl, gl = att_project(hl, att_w_in[j], att_q_norm[j], att_k_norm[j])
            ql = apply_rope(ql, cos, sin)
            kl = apply_rope(kl, cos, sin)
            keys = jnp.concatenate([cache_k[:, j].astype(kl.dtype), kl], axis=1)
            vals = jnp.concatenate([cache_v[:, j].astype(vl.dtype), vl], axis=1)
            ol = (attention(ql, keys, vals) * jax.nn.silu(gl)) @ att_w_out[j]
        xc = xc + gt_c * rmsnorm(oc, norm_post[i])
        xl = xl + gt_l * rmsnorm(ol, norm_post[i])

    return (xc, xl, jnp.stack(new_states, axis=1), jnp.stack(new_k, axis=1), jnp.stack(new_v, axis=1))
```

```cpp
#include <hip/hip_runtime.h>
#include <hip/hip_cooperative_groups.h>
#include <cstdio>
#include <cstdint>
namespace cg = cooperative_groups;

#ifndef MULTI_LAUNCH
#define MULTI_LAUNCH 0
#endif
#define REP_PREP 1
#define REP_GEMM 1
#define REP_SCAN 1
#define REP_CHAIN 1
#define REP_COMB 1
#define REP_ATT 1
#define EXTRA_SYNC 0

typedef unsigned short bf16_t;
typedef short bf16x8 __attribute__((ext_vector_type(8)));
typedef short bf16x4 __attribute__((ext_vector_type(4)));
typedef float f32x4 __attribute__((ext_vector_type(4)));
typedef float f32x16 __attribute__((ext_vector_type(16)));

#define DI __device__ __forceinline__

constexpr int DM = 1024;
constexpr int NTOK = 12288;
constexpr int NCTX = 4096;
constexpr int ZN_REC = 3584;
constexpr int ZN_ATT = 2560;
constexpr int NTHR = 512;
constexpr int LDS_BYTES = 131072;
constexpr float EPS = 1e-6f;
constexpr int NPHASE = 24;

struct Params;
typedef const __attribute__((address_space(4))) Params* PP;
struct Params {
  const float *x_prompt, *x_sample, *c, *state, *cache_k, *cache_v, *c_ctx, *ada_w, *ada_b, *norm_pre, *norm_post;
  const float *rec_w_in, *rec_lb, *rec_head_norm, *pool_w, *pool_scale, *rec_w_out, *att_w_in, *att_q_norm, *att_k_norm, *att_w_out;
  float* out;
  bf16_t *WrecT, *WrecoT, *WattT, *WattoT;
  float *mod, *lb, *ropec, *ropes;
  bf16_t *h, *z, *r;
  float* oproj;
  bf16_t *Kc, *Kl, *Vc, *Vl;
  unsigned* bar;
  int ph_lo, ph_hi, coop, pad;
};

DI bf16_t f2bf(float f) { unsigned u = __float_as_uint(f); u += 0x7fffu + ((u >> 16) & 1u); return (bf16_t)(u >> 16); }
DI float bf2f(bf16_t b) { return __uint_as_float(((unsigned)b) << 16); }
DI float bfs(short b) { return __uint_as_float(((unsigned)(unsigned short)b) << 16); }
typedef __bf16 bf16v2_t __attribute__((ext_vector_type(2)));
typedef float f32v2_t __attribute__((ext_vector_type(2)));
DI unsigned pk2(float a, float b) { f32v2_t v = {a, b}; return __builtin_bit_cast(unsigned, __builtin_convertvector(v, bf16v2_t)); }
DI float wave_sum(float v) {
  { auto r = __builtin_amdgcn_permlane32_swap(__float_as_uint(v), __float_as_uint(v), false, false); v = __uint_as_float(r[0]) + __uint_as_float(r[1]); }
  { auto r = __builtin_amdgcn_permlane16_swap(__float_as_uint(v), __float_as_uint(v), false, false); v = __uint_as_float(r[0]) + __uint_as_float(r[1]); }
  v += __uint_as_float(__builtin_amdgcn_update_dpp(0, __float_as_uint(v), 0x128, 0xf, 0xf, false));
  v += __uint_as_float(__builtin_amdgcn_update_dpp(0, __float_as_uint(v), 0x124, 0xf, 0xf, false));
  v += __uint_as_float(__builtin_amdgcn_update_dpp(0, __float_as_uint(v), 0x122, 0xf, 0xf, false));
  v += __uint_as_float(__builtin_amdgcn_update_dpp(0, __float_as_uint(v), 0x121, 0xf, 0xf, false));
  return v;
}
typedef unsigned u32x4_t __attribute__((ext_vector_type(4)));
DI void st16_wt(void* ptr, uint4 v) { u32x4_t w = {v.x, v.y, v.z, v.w}; asm volatile("global_store_dwordx4 %0, %1, off sc1\n\ts_nop 1" :: "v"(ptr), "v"(w) : "memory"); }
DI void lds_barrier() { asm volatile("s_waitcnt lgkmcnt(0)\n\ts_barrier" ::: "memory"); }
DI float silu_f(float x) { return x * __builtin_amdgcn_rcpf(1.f + __expf(-x)); }
DI f32x16 mfma32(bf16x8 a, bf16x8 b, f32x16 c) { return __builtin_amdgcn_mfma_f32_32x32x16_bf16(a, b, c, 0, 0, 0); }
DI bf16x8 pack8(const f32x16& x, int s) {
  uint4 w;
  w.x = pk2(x[8 * s + 0], x[8 * s + 1]); w.y = pk2(x[8 * s + 2], x[8 * s + 3]);
  w.z = pk2(x[8 * s + 4], x[8 * s + 5]); w.w = pk2(x[8 * s + 6], x[8 * s + 7]);
  return __builtin_bit_cast(bf16x8, w);
}

DI void tr_tile(const float* src, int ld, int k0, int n0, bf16_t* dst, int nd0, float* T) {
  const int tid = threadIdx.x;
#pragma unroll
  for (int i = 0; i < 2; ++i) {
    int idx = tid + 512 * i, kk = idx >> 4, c4 = idx & 15;
    f32x4 v = *(const f32x4*)(src + (size_t)(k0 + kk) * ld + n0 + c4 * 4);
    T[kk * 65 + c4 * 4 + 0] = v[0]; T[kk * 65 + c4 * 4 + 1] = v[1]; T[kk * 65 + c4 * 4 + 2] = v[2]; T[kk * 65 + c4 * 4 + 3] = v[3];
  }
  __syncthreads();
  {
    int nn = tid >> 3, k8 = (tid & 7) * 8;
    uint4 o;
    o.x = pk2(T[(k8 + 0) * 65 + nn], T[(k8 + 1) * 65 + nn]);
    o.y = pk2(T[(k8 + 2) * 65 + nn], T[(k8 + 3) * 65 + nn]);
    o.z = pk2(T[(k8 + 4) * 65 + nn], T[(k8 + 5) * 65 + nn]);
    o.w = pk2(T[(k8 + 6) * 65 + nn], T[(k8 + 7) * 65 + nn]);
    *(uint4*)(dst + (size_t)(nd0 + nn) * 1024 + k0 + k8) = o;
  }
  __syncthreads();
}

constexpr int J_MOD = 192, J_FOLD = 128, J_MISC = 8;
constexpr int J_TR_REC = 16 * 48, J_TR_RECO = 256, J_TR_ATT = 16 * 40, J_TR_ATTO = 256;
constexpr int J_TR_PER = J_TR_REC + J_TR_RECO + J_TR_ATT + J_TR_ATTO;
constexpr int J_TOTAL = J_MOD + J_FOLD + J_MISC + 2 * J_TR_PER;

constexpr int J_FIRST = J_MOD + J_FOLD + J_MISC;
DI int map_job(int group, int v) {
  if (group == 0) {
    if (v < 192) return v;
    v -= 192; if (v < 8) return 320 + v;
    v -= 8; if (v < 128) return 192 + v;
    v -= 128; if (v < 1024) return J_FIRST + v;
    return -1;
  } else if (group == 1) {
    return (v < 896) ? J_FIRST + 1024 + v : -1;
  } else if (group == 2) {
    return (v < 1024) ? J_FIRST + J_TR_PER + v : -1;
  } else {
    return (v < 896) ? J_FIRST + J_TR_PER + 1024 + v : -1;
  }
}
DI void prep_jobs(PP p, unsigned char* smem, int group, int vb, int nb) {
  const int tid = threadIdx.x, wave = tid >> 6, lane = tid & 63;
  int v = vb;
  for (;; v += nb) {
    const int job = map_job(group, v);
    if (job < 0 || job >= J_FIRST) break;
    int jb = job;
    if (jb < J_MOD) {
      const int i = jb / 48, col0 = (jb % 48) * 64;
      float* sv = (float*)smem;
      float* red = sv + 9 * 1024;
      for (int e = tid; e < 9 * 1024; e += NTHR) {
        int r = e >> 10, k = e & 1023;
        float cv = (r == 0) ? p->c_ctx[k] : p->c[(r - 1) * 1024 + k];
        sv[e] = silu_f(cv);
      }
      __syncthreads();
      float acc[9];
#pragma unroll
      for (int r = 0; r < 9; ++r) acc[r] = 0.f;
      const float* wp = p->ada_w + ((size_t)i * 1024 + wave * 128) * 3072 + col0 + lane;
#pragma unroll 16
      for (int k = 0; k < 128; ++k) {
        float wv = wp[(size_t)k * 3072];
#pragma unroll
        for (int r = 0; r < 9; ++r) acc[r] += sv[r * 1024 + wave * 128 + k] * wv;
      }
#pragma unroll
      for (int r = 0; r < 9; ++r) red[(wave * 9 + r) * 64 + lane] = acc[r];
      __syncthreads();
      for (int e = tid; e < 9 * 64; e += NTHR) {
        int r = e >> 6, l = e & 63;
        float s = 0.f;
#pragma unroll
        for (int w = 0; w < 8; ++w) s += red[(w * 9 + r) * 64 + l];
        p->mod[((size_t)i * 9 + r) * 3072 + col0 + l] = s + p->ada_b[i * 3072 + col0 + l];
      }
      __syncthreads();
      continue;
    }
    jb -= J_MOD;
    if (jb < J_FOLD) {
      const int j = jb >> 6, g = (jb >> 4) & 3, kt = jb & 15, k0 = kt * 64;
      float* Wt = (float*)smem;
      for (int e = tid; e < 64 * 32; e += NTHR) {
        int kk = e >> 5, c4 = e & 31;
        f32x4 v = *(const f32x4*)(p->rec_w_in + ((size_t)j * 1024 + k0 + kk) * ZN_REC + g * 128 + c4 * 4);
        Wt[kk * 129 + c4 * 4 + 0] = v[0]; Wt[kk * 129 + c4 * 4 + 1] = v[1]; Wt[kk * 129 + c4 * 4 + 2] = v[2]; Wt[kk * 129 + c4 * 4 + 3] = v[3];
      }
      __syncthreads();
      const int cp = tid & 127, kq = tid >> 7;
      float acc[16];
#pragma unroll
      for (int i = 0; i < 16; ++i) acc[i] = 0.f;
      const float* pw = p->pool_w + ((size_t)(j * 4 + g) * 128) * 128 + cp;
      for (int c = 0; c < 128; ++c) {
        float w = pw[(size_t)c * 128];
#pragma unroll
        for (int i = 0; i < 16; ++i) acc[i] += Wt[(kq * 16 + i) * 129 + c] * w;
      }
      float sc = p->pool_scale[j * 512 + g * 128 + cp];
      uint4 o0, o1;
      o0.x = pk2(acc[0] * sc, acc[1] * sc); o0.y = pk2(acc[2] * sc, acc[3] * sc); o0.z = pk2(acc[4] * sc, acc[5] * sc); o0.w = pk2(acc[6] * sc, acc[7] * sc);
      o1.x = pk2(acc[8] * sc, acc[9] * sc); o1.y = pk2(acc[10] * sc, acc[11] * sc); o1.z = pk2(acc[12] * sc, acc[13] * sc); o1.w = pk2(acc[14] * sc, acc[15] * sc);
      bf16_t* dp = p->WrecT + ((size_t)j * ZN_REC + g * 128 + cp) * 1024 + k0 + kq * 16;
      *(uint4*)dp = o0; *(uint4*)(dp + 8) = o1;
      __syncthreads();
      continue;
    }
    jb -= J_FOLD;
    if (jb < J_MISC) {
      for (int e = tid; e < 128 * 64; e += NTHR) {
        int t = jb * 128 + (e >> 6), i = e & 63;
        int fi = i & 31;
        float inv = exp2f(-(float)(2 * fi) * (13.287712379549449f / 64.f));
        float pos = (i < 32) ? (float)(t >> 6) : (float)(t & 63);
        float ang = pos * inv;
        p->ropec[t * 64 + i] = __cosf(ang);
        p->ropes[t * 64 + i] = __sinf(ang);
      }
      if (jb == 0) {
        for (int e = tid; e < 1024; e += NTHR) {
          float a0 = p->rec_lb[e], a1 = p->rec_lb[1024 + e];
          float mx = fmaxf(a0, a1);
          float e0 = __expf(a0 - mx), e1 = __expf(a1 - mx);
          float p1 = e1 / (e0 + e1);
          p->lb[e] = 0.f;
          p->lb[1024 + e] = fminf(fmaxf(p1, 0.f), 1.f);
        }
      }
      continue;
    }
  }
  {
    int job = map_job(group, v);
    float* T = (float*)smem;
    const float* src = nullptr; bf16_t* dst = nullptr; int ld = 0;
    f32x4 v0, v1;
#define TR_DECODE(jobid) do { int jb_ = (jobid) - J_FIRST; const int j_ = jb_ / J_TR_PER; int t_ = jb_ % J_TR_PER; int kt_, nt_; \
      if (t_ < J_TR_REC) { kt_ = t_ / 48; nt_ = t_ % 48 + 8; ld = ZN_REC; src = p->rec_w_in + (size_t)j_ * 1024 * ZN_REC; dst = p->WrecT + (size_t)j_ * ZN_REC * 1024; } \
      else if ((t_ -= J_TR_REC) < J_TR_RECO) { kt_ = t_ / 16; nt_ = t_ % 16; ld = 1024; src = p->rec_w_out + (size_t)j_ * 1024 * 1024; dst = p->WrecoT + (size_t)j_ * 1024 * 1024; } \
      else if ((t_ -= J_TR_RECO) < J_TR_ATT) { kt_ = t_ / 40; nt_ = t_ % 40; ld = ZN_ATT; src = p->att_w_in + (size_t)j_ * 1024 * ZN_ATT; dst = p->WattT + (size_t)j_ * ZN_ATT * 1024; } \
      else { t_ -= J_TR_ATT; kt_ = t_ / 16; nt_ = t_ % 16; ld = 1024; src = p->att_w_out + (size_t)j_ * 1024 * 1024; dst = p->WattoT + (size_t)j_ * 1024 * 1024; } \
      src += (size_t)(kt_ * 64) * ld + nt_ * 64; dst += (size_t)(nt_ * 64) * 1024 + kt_ * 64; } while (0)
#define TR_LOAD() do { v0 = *(const f32x4*)(src + (size_t)(tid >> 4) * ld + (tid & 15) * 4); v1 = *(const f32x4*)(src + (size_t)((tid >> 4) + 32) * ld + (tid & 15) * 4); } while (0)
    if (job >= 0) { TR_DECODE(job); TR_LOAD(); }
    while (job >= 0) {
      bf16_t* dcur = dst;
      {
        const int kk = tid >> 4, c4 = tid & 15;
        T[kk * 65 + c4 * 4 + 0] = v0[0]; T[kk * 65 + c4 * 4 + 1] = v0[1]; T[kk * 65 + c4 * 4 + 2] = v0[2]; T[kk * 65 + c4 * 4 + 3] = v0[3];
        T[(kk + 32) * 65 + c4 * 4 + 0] = v1[0]; T[(kk + 32) * 65 + c4 * 4 + 1] = v1[1]; T[(kk + 32) * 65 + c4 * 4 + 2] = v1[2]; T[(kk + 32) * 65 + c4 * 4 + 3] = v1[3];
      }
      lds_barrier();
      v += nb; job = map_job(group, v);
      if (job >= 0) { TR_DECODE(job); TR_LOAD(); }
      {
        const int nn = tid >> 3, k8 = (tid & 7) * 8;
        uint4 o;
        o.x = pk2(T[(k8 + 0) * 65 + nn], T[(k8 + 1) * 65 + nn]);
        o.y = pk2(T[(k8 + 2) * 65 + nn], T[(k8 + 3) * 65 + nn]);
        o.z = pk2(T[(k8 + 4) * 65 + nn], T[(k8 + 5) * 65 + nn]);
        o.w = pk2(T[(k8 + 6) * 65 + nn], T[(k8 + 7) * 65 + nn]);
        *(uint4*)(dcur + (size_t)nn * 1024 + k8) = o;
      }
      lds_barrier();
    }
#undef TR_DECODE
#undef TR_LOAD
  }
  __syncthreads();
}

#define ROW_ST16(BASE, Q) do { _Pragma("unroll") for (int jp_ = 0; jp_ < 2; ++jp_) { \
    const uint2 mine0_ = (Q)[2 * jp_], mine1_ = (Q)[2 * jp_ + 1]; const bool odd_ = lane & 1; \
    const unsigned sx_ = odd_ ? mine0_.x : mine1_.x, sy_ = odd_ ? mine0_.y : mine1_.y; \
    const unsigned rx_ = (unsigned)__builtin_amdgcn_update_dpp(0, (int)sx_, 0xB1, 0xf, 0xf, false), ry_ = (unsigned)__builtin_amdgcn_update_dpp(0, (int)sy_, 0xB1, 0xf, 0xf, false); \
    const uint4 w_ = odd_ ? make_uint4(rx_, ry_, mine1_.x, mine1_.y) : make_uint4(mine0_.x, mine0_.y, rx_, ry_); \
    st16_wt((BASE) + (size_t)row * DM + (lane & ~1) * 4 + (2 * jp_ + (odd_ ? 1 : 0)) * 256, w_); } } while (0)
DI void phase_row(PP p, int li) {
  const int wave = threadIdx.x >> 6, lane = threadIdx.x & 63;
  const int nl = li + 1;
  bf16_t* xz = p->z + (size_t)NTOK * ZN_ATT;
  bf16_t* xy = (bf16_t*)p->out;
  const bf16_t* xsrc = (li == 2) ? xy : xz;
  bf16_t* xdst = (li == 1) ? xy : xz;
  for (int pi = blockIdx.x * 8 + wave; pi < NTOK / 2; pi += gridDim.x * 8) {
    const int row0 = 2 * pi;
    const int mr = (row0 < NCTX) ? 0 : 1 + ((row0 - NCTX) >> 10);
    f32x4 x[2][4], o[2][4], gt[4], npo[4], sh[4], sc[4], npr[4];
#pragma unroll
    for (int r = 0; r < 2; ++r) {
      const int row = row0 + r;
      if (li <= 0) {
        const float* xin = (row < NCTX) ? p->x_prompt + (size_t)row * DM : p->x_sample + (size_t)(row - NCTX) * DM;
#pragma unroll
        for (int j = 0; j < 4; ++j) x[r][j] = *(const f32x4*)(xin + lane * 4 + j * 256);
      } else {
#pragma unroll
        for (int j = 0; j < 4; ++j) {
          const uint2 ux = *(const uint2*)(xsrc + (size_t)row * DM + lane * 4 + j * 256);
          x[r][j] = (f32x4){__uint_as_float(ux.x << 16), __uint_as_float(ux.x & 0xffff0000u), __uint_as_float(ux.y << 16), __uint_as_float(ux.y & 0xffff0000u)};
        }
      }
      if (li >= 0) {
#pragma unroll
        for (int j = 0; j < 4; ++j) {
          const uint2 uo = *(const uint2*)((const bf16_t*)p->oproj + (size_t)row * DM + lane * 4 + j * 256);
          o[r][j] = (f32x4){__uint_as_float(uo.x << 16), __uint_as_float(uo.x & 0xffff0000u), __uint_as_float(uo.y << 16), __uint_as_float(uo.y & 0xffff0000u)};
        }
      }
    }
    if (li >= 0) {
#pragma unroll
      for (int j = 0; j < 4; ++j) {
        gt[j] = *(const f32x4*)(p->mod + ((size_t)li * 9 + mr) * 3072 + 2048 + lane * 4 + j * 256);
        npo[j] = *(const f32x4*)(p->norm_post + li * DM + lane * 4 + j * 256);
      }
    }
    if (nl < 4) {
#pragma unroll
      for (int j = 0; j < 4; ++j) {
        sh[j] = *(const f32x4*)(p->mod + ((size_t)nl * 9 + mr) * 3072 + lane * 4 + j * 256);
        sc[j] = *(const f32x4*)(p->mod + ((size_t)nl * 9 + mr) * 3072 + 1024 + lane * 4 + j * 256);
        npr[j] = *(const f32x4*)(p->norm_pre + nl * DM + lane * 4 + j * 256);
      }
    }
    if (li >= 0) {
      float ss[2];
#pragma unroll
      for (int r = 0; r < 2; ++r) {
        float s_ = 0.f;
#pragma unroll
        for (int j = 0; j < 4; ++j) s_ += o[r][j][0] * o[r][j][0] + o[r][j][1] * o[r][j][1] + o[r][j][2] * o[r][j][2] + o[r][j][3] * o[r][j][3];
        ss[r] = s_;
      }
      ss[0] = wave_sum(ss[0]); ss[1] = wave_sum(ss[1]);
#pragma unroll
      for (int r = 0; r < 2; ++r) {
        const float rstd = rsqrtf(ss[r] * (1.f / DM) + EPS);
#pragma unroll
        for (int j = 0; j < 4; ++j) x[r][j] = x[r][j] + gt[j] * (o[r][j] * rstd * npo[j]);
      }
    }
    uint2 hq[2][4];
    if (nl < 4) {
      float ss[2];
#pragma unroll
      for (int r = 0; r < 2; ++r) {
        float s_ = 0.f;
#pragma unroll
        for (int j = 0; j < 4; ++j) s_ += x[r][j][0] * x[r][j][0] + x[r][j][1] * x[r][j][1] + x[r][j][2] * x[r][j][2] + x[r][j][3] * x[r][j][3];
        ss[r] = s_;
      }
      ss[0] = wave_sum(ss[0]); ss[1] = wave_sum(ss[1]);
#pragma unroll
      for (int r = 0; r < 2; ++r) {
        const float rstd = rsqrtf(ss[r] * (1.f / DM) + EPS);
#pragma unroll
        for (int j = 0; j < 4; ++j) {
          f32x4 hv = x[r][j] * rstd * npr[j] * (sc[j] + 1.f) + sh[j];
          hq[r][j].x = pk2(hv[0], hv[1]); hq[r][j].y = pk2(hv[2], hv[3]);
        }
      }
    }
#pragma unroll
    for (int r = 0; r < 2; ++r) {
      const int row = row0 + r;
      if (li == 3) {
#pragma unroll
        for (int j = 0; j < 4; ++j) *(f32x4*)(p->out + (size_t)row * DM + lane * 4 + j * 256) = x[r][j];
      } else if (li >= 0) {
        uint2 xq[4];
#pragma unroll
        for (int j = 0; j < 4; ++j) { xq[j].x = pk2(x[r][j][0], x[r][j][1]); xq[j].y = pk2(x[r][j][2], x[r][j][3]); }
        ROW_ST16(xdst, xq);
      }
      if (nl < 4) ROW_ST16(p->h, hq[r]);
    }
  }
}

#define LAS __attribute__((address_space(3)))
constexpr int BM = 256, BK = 64, HALF = 128, HTB = HALF * BK * 2, NXCD = 8, WGM = 8;
DI int lds_byte(int r, int c) { const int st = (r >> 4) * 2 + (c >> 5), rr = r & 15, cc = c & 31, ob = rr * 64 + cc * 2; return st * 1024 + (ob ^ (((ob >> 9) & 1) << 5)); }
DI void stage_rc(int b, int& R, int& C) { const int st = b / 1024, sb = b % 1024, swz = sb ^ (((sb >> 9) & 1) << 5); R = (st >> 1) * 16 + swz / 64; C = (st & 1) * 32 + (swz % 64) / 2; }
DI int perm32(int rho) { const int n = rho >> 4, i = rho & 15; return 8 * (i >> 2) + 4 * n + (i & 3); }
struct Unit { int pm, pn; };
struct StaticOrder {
  int nM, nN, nwg, G, c;
  DI void init(int M, int N, int G_, int c_) { nM = M / BM; nN = N / BM; nwg = nM * nN; G = G_; c = c_; }
  DI bool next(int i, Unit& u) const {
    const long L = (long)i * G + c; if (L >= nwg) return false;
    int wgid = (int)L; { const int q = nwg / NXCD, r = nwg % NXCD, xcd = wgid % NXCD, off = wgid / NXCD; wgid = (xcd < r ? xcd * (q + 1) : r * (q + 1) + (xcd - r) * q) + off; }
    const int nig = WGM * nN, gid = wgid / nig, fm = gid * WGM, gsz = (nM - fm) < WGM ? (nM - fm) : WGM;
    u.pm = fm + ((wgid % nig) % gsz); u.pn = (wgid % nig) / gsz; return true;
  }
};
struct EpiF32 {
  static constexpr bool PERM = false;
  float* C; int ldc;
  DI void operator()(const f32x4 (&acc)[2][2][4][2], const Unit& u, int wr, int wc, int fr, int fq) const {
    const int row0 = u.pm * BM + wr * 64 + fr, col0 = u.pn * BM + wc * 32 + 4 * fq;
#pragma unroll
    for (int ai = 0; ai < 2; ++ai)
#pragma unroll
      for (int m = 0; m < 4; ++m) { float* rowp = C + (size_t)(row0 + ai * HALF + m * 16) * ldc + col0;
#pragma unroll
        for (int bj = 0; bj < 2; ++bj)
#pragma unroll
          for (int n = 0; n < 2; ++n) *(f32x4*)(rowp + bj * HALF + n * 16) = acc[ai][bj][m][n]; }
  }
};
struct EpiBf16 {
  static constexpr bool PERM = true;
  bf16_t* O; int ldc;
  DI void operator()(const f32x4 (&acc)[2][2][4][2], const Unit& u, int wr, int wc, int fr, int fq) const {
    const int row0 = u.pm * BM + wr * 64 + fr, col0 = u.pn * BM + wc * 32 + 8 * fq;
#pragma unroll
    for (int ai = 0; ai < 2; ++ai)
#pragma unroll
      for (int m = 0; m < 4; ++m) { bf16_t* rowp = O + (size_t)(row0 + ai * HALF + m * 16) * ldc + col0;
#pragma unroll
        for (int bj = 0; bj < 2; ++bj) { const f32x4 v0 = acc[ai][bj][m][0], v1 = acc[ai][bj][m][1];
          uint4 o; o.x = pk2(v0[0], v0[1]); o.y = pk2(v0[2], v0[3]); o.z = pk2(v1[0], v1[1]); o.w = pk2(v1[2], v1[3]);
          st16_wt(rowp + bj * HALF, o); } }
  }
};

struct RecOrder {
  int base, end, G, c;
  DI bool next(int i, Unit& u) const {
    const int L = base + i * G + c; if (L >= end) return false;
    const bool p2 = L >= 384; const int nN = p2 ? 6 : 8, nwg = 48 * nN;
    int wgid = p2 ? L - 384 : L;
    { const int q = nwg / NXCD, r = nwg % NXCD, xcd = wgid % NXCD, off = wgid / NXCD; wgid = (xcd < r ? xcd * (q + 1) : r * (q + 1) + (xcd - r) * q) + off; }
    const int nig = WGM * nN, gid = wgid / nig, fm = gid * WGM, gsz = (48 - fm) < WGM ? (48 - fm) : WGM;
    u.pm = fm + ((wgid % nig) % gsz);
    const int pl = (wgid % nig) / gsz;
    u.pn = p2 ? ((pl < 4) ? pl : 8 + pl) : 4 + pl;
    return true;
  }
};
template <class Epi, class Sched>
DI void phase_gemm_s(const bf16_t* gA, const bf16_t* gBt, const Epi& E, const Sched& S, unsigned char* smem);
template <class Epi>
DI void phase_gemm(const bf16_t* gA, const bf16_t* gBt, int N, const Epi& E, unsigned char* smem) {
  StaticOrder S; S.init(NTOK, N, (int)gridDim.x, (int)blockIdx.x);
  phase_gemm_s(gA, gBt, E, S, smem);
}
template <class Epi, class Sched>
DI void phase_gemm_s(const bf16_t* gA, const bf16_t* gBt, const Epi& E, const Sched& S, unsigned char* smem) {
  LAS unsigned char* lds = (LAS unsigned char*)smem;
  const int tid = threadIdx.x, wid = __builtin_amdgcn_readfirstlane(tid >> 6), lane = tid & 63, wr = wid >> 2, wc = wid & 3, fr = lane & 15, fq = lane >> 4;
  constexpr int K = 1024, nt = K / BK;
  unsigned voffA[2], voffB[2];
#pragma unroll
  for (int i = 0; i < 2; ++i) { int R, C; stage_rc(tid * 16 + i * 8192, R, C); const int Rb = Epi::PERM ? ((R & ~31) + perm32(R & 31)) : R;
    voffA[i] = (unsigned)(R * K + C) * 2u; voffB[i] = (unsigned)(Rb * K + C) * 2u; }
  const size_t kstep = (size_t)(BK * 2);
  const size_t hstep = (size_t)HALF * K * 2;
  const size_t tstep = 2 * hstep;
  const unsigned ldsw = (unsigned)wid * 1024u;
  const int aoff = lds_byte(wr * 64 + fr, fq * 8), boff = lds_byte(wc * 32 + fr, fq * 8);
#define PG8_SA(b, h) (((b) * 2 + (h)) * HTB)
#define PG8_SB(b, h) ((4 + (b) * 2 + (h)) * HTB)
#define PG8_STAGE(bufoff, gbase, voff) do { _Pragma("unroll") for (int _i = 0; _i < 2; ++_i) \
    __builtin_amdgcn_global_load_lds((const unsigned*)((const char*)(gbase) + (voff)[_i]), (LAS unsigned*)(lds + (bufoff) + ldsw + _i * 8192), 16, 0, 0); } while (0)
#define PG8_LDA(dst, b, h) do { _Pragma("unroll") for (int m = 0; m < 4; ++m) _Pragma("unroll") for (int k = 0; k < 2; ++k) dst[m][k] = *(const LAS bf16x8*)(lds + PG8_SA(b, h) + aoff + m * 2048 + k * 1024); } while (0)
#define PG8_LDB(dst, b, h) do { _Pragma("unroll") for (int n = 0; n < 2; ++n) _Pragma("unroll") for (int k = 0; k < 2; ++k) dst[n][k] = *(const LAS bf16x8*)(lds + PG8_SB(b, h) + boff + n * 2048 + k * 1024); } while (0)
#define PG8_MMA(ai, bj, At, Bt) do { __builtin_amdgcn_s_setprio(1); _Pragma("unroll") for (int m = 0; m < 4; ++m) _Pragma("unroll") for (int n = 0; n < 2; ++n) _Pragma("unroll") for (int k = 0; k < 2; ++k) \
    acc[ai][bj][m][n] = __builtin_amdgcn_mfma_f32_16x16x32_bf16(Bt[n][k], At[m][k], acc[ai][bj][m][n], 0, 0, 0); __builtin_amdgcn_s_setprio(0); } while (0)
#define PG8_WAIT_V(n) asm volatile("s_waitcnt vmcnt(" #n ")" ::: "memory")
#define PG8_WAIT_L(n) asm volatile("s_waitcnt lgkmcnt(" #n ")" ::: "memory")
#define PG8_BAR __builtin_amdgcn_s_barrier()
#define PG8_SCHED __builtin_amdgcn_sched_barrier(0)
  Unit cur, nxt; int ui = 0;
  if (S.next(0, cur)) {
    f32x4 acc[2][2][4][2];
#pragma unroll
    for (int a = 0; a < 2; ++a)
#pragma unroll
      for (int b = 0; b < 2; ++b)
#pragma unroll
        for (int m = 0; m < 4; ++m)
#pragma unroll
          for (int n = 0; n < 2; ++n) acc[a][b][m][n] = (f32x4){0.f, 0.f, 0.f, 0.f};
    bf16x8 At[4][2], B0[2][2], B1[2][2];
    const char* cA = (const char*)gA + (size_t)cur.pm * tstep; const char* cB = (const char*)gBt + (size_t)cur.pn * tstep;
    PG8_STAGE(PG8_SB(0, 0), cB, voffB); PG8_STAGE(PG8_SA(0, 0), cA, voffA); PG8_STAGE(PG8_SB(0, 1), cB + hstep, voffB); PG8_STAGE(PG8_SA(0, 1), cA + hstep, voffA);
    if (wr == 1) PG8_BAR;
    PG8_WAIT_V(4); PG8_BAR;
    PG8_STAGE(PG8_SB(1, 0), cB + kstep, voffB); PG8_STAGE(PG8_SA(1, 0), cA + kstep, voffA); PG8_STAGE(PG8_SB(1, 1), cB + hstep + kstep, voffB);
    PG8_WAIT_V(6); PG8_BAR;
    for (;;) {
      const bool has_next = S.next(ui + 1, nxt);
      const char* nA = has_next ? (const char*)gA + (size_t)nxt.pm * tstep : cA; const char* nB = has_next ? (const char*)gBt + (size_t)nxt.pn * tstep : cB;
      for (int t = 0; t < nt; t += 2) {
        const bool last = (t == nt - 2);
        const char* a1 = cA + (size_t)(t + 1) * kstep;
        const char* a2 = last ? nA : cA + (size_t)(t + 2) * kstep; const char* b2 = last ? nB : cB + (size_t)(t + 2) * kstep;
        const char* a3 = a2 + kstep; const char* b3 = b2 + kstep;
        PG8_LDB(B0, 0, 0); PG8_SCHED; PG8_LDA(At, 0, 0); PG8_STAGE(PG8_SA(1, 1), a1 + hstep, voffA);
        PG8_WAIT_L(8); PG8_BAR; PG8_WAIT_L(0); PG8_MMA(0, 0, At, B0); PG8_BAR; PG8_SCHED;
        PG8_LDB(B1, 0, 1); PG8_STAGE(PG8_SB(0, 0), b2, voffB);
        PG8_BAR; PG8_WAIT_L(0); PG8_MMA(0, 1, At, B1); PG8_BAR;
        PG8_LDA(At, 0, 1); PG8_STAGE(PG8_SA(0, 0), a2, voffA);
        PG8_BAR; PG8_WAIT_L(0); PG8_MMA(1, 0, At, B0); PG8_BAR; PG8_SCHED;
        PG8_STAGE(PG8_SB(0, 1), b2 + hstep, voffB);
        PG8_WAIT_V(6); PG8_BAR; PG8_MMA(1, 1, At, B1); PG8_BAR;
        PG8_LDB(B0, 1, 0); PG8_SCHED; PG8_LDA(At, 1, 0); PG8_STAGE(PG8_SA(0, 1), a2 + hstep, voffA);
        PG8_WAIT_L(8); PG8_BAR; PG8_WAIT_L(0); PG8_MMA(0, 0, At, B0); PG8_BAR; PG8_SCHED;
        PG8_LDB(B1, 1, 1); PG8_STAGE(PG8_SB(1, 0), b3, voffB);
        PG8_BAR; PG8_WAIT_L(0); PG8_MMA(0, 1, At, B1); PG8_BAR;
        PG8_LDA(At, 1, 1); PG8_STAGE(PG8_SA(1, 0), a3, voffA);
        PG8_BAR; PG8_WAIT_L(0); PG8_MMA(1, 0, At, B0); PG8_BAR; PG8_SCHED;
        PG8_STAGE(PG8_SB(1, 1), b3 + hstep, voffB);
        PG8_WAIT_V(6); PG8_BAR; PG8_MMA(1, 1, At, B1); PG8_BAR;
      }
      E(acc, cur, wr, wc, fr, fq);
      if (!has_next) break;
#pragma unroll
      for (int a = 0; a < 2; ++a)
#pragma unroll
        for (int b = 0; b < 2; ++b)
#pragma unroll
          for (int m = 0; m < 4; ++m)
#pragma unroll
            for (int n = 0; n < 2; ++n) acc[a][b][m][n] = (f32x4){0.f, 0.f, 0.f, 0.f};
      cur = nxt; cA = nA; cB = nB; ++ui;
    }
    PG8_WAIT_V(0);
    if (wr == 0) PG8_BAR;
    PG8_BAR;
  }
  __syncthreads();
#undef PG8_SA
#undef PG8_SB
#undef PG8_STAGE
#undef PG8_LDA
#undef PG8_LDB
#undef PG8_MMA
}

constexpr int REC_BYTES = 28672, REC_QF = 0, REC_KF = 8192, REC_VF = 16384, REC_PF = 24576, REC_AL = 26624;
constexpr int N_REC_A = 877;
DI unsigned char* rec_ptr(PP p, int it) {
  return (it < N_REC_A) ? ((unsigned char*)p->oproj + (size_t)NTOK * 512 * 4 + (size_t)it * REC_BYTES)
                        : ((unsigned char*)p->h + (size_t)(it - N_REC_A) * REC_BYTES);
}
struct PrepSlot { float* LF; bf16_t *Qin, *Qt, *Kt, *KoT, *VT; float *AL, *EM, *ELM; };
DI PrepSlot prep_slot(unsigned char* smem, int s) {
  unsigned char* b = smem + s * 61440;
  PrepSlot L;
  L.LF = (float*)b;
  L.Qin = (bf16_t*)(b + 16384);
  L.Qt = L.Qin + 32 * 136;
  L.Kt = L.Qt + 32 * 136;
  L.KoT = L.Kt + 32 * 136;
  L.VT = L.KoT + 32 * 136;
  L.AL = (float*)(L.VT + 32 * 136);
  L.EM = L.AL + 128;
  L.ELM = L.EM + 128;
  return L;
}
struct PrepRegs { bf16x8 q8, f8, v8; f32x4 lwa, lwb; };
DI void prep_load(PP p, int j, int item, int t, int d0, PrepRegs& R) {
  const int dir = item & 1, hd = (item >> 1) & 3, ck = item >> 3;
  const bf16_t* zr = p->z + (size_t)(ck * 32 + (dir ? 31 - t : t)) * ZN_REC + hd * 128 + d0;
  R.q8 = *(const bf16x8*)(zr + 1024); R.f8 = *(const bf16x8*)(zr + (dir ? 2048 : 1536)); R.v8 = *(const bf16x8*)(zr + 2560);
  const float* lp = p->lb + (j * 2 + dir) * 512 + hd * 128 + d0;
  R.lwa = *(const f32x4*)lp; R.lwb = *(const f32x4*)(lp + 4);
}
DI void prep_stepA(const PrepSlot& L, const PrepRegs& R, int t, int d0, float (&sq)[8], float (&kk)[8]) {
  float lf[8];
#pragma unroll
  for (int i = 0; i < 8; ++i) {
    const float lw = (i < 4) ? R.lwa[i & 3] : R.lwb[i & 3];
    const float zf = bfs(R.f8[i]);
    const float sg = __builtin_amdgcn_rcpf(1.f + __builtin_amdgcn_exp2f(-1.4426950408889634f * zf));
    float f = lw + (1.f - lw) * sg;
    f = fminf(fmaxf(f, 1e-6f), 1.f);
    lf[i] = __builtin_amdgcn_logf(f);
    kk[i] = 1.f - f;
    sq[i] = silu_f(bfs(R.q8[i]));
  }
  *(f32x4*)(L.LF + t * 128 + d0) = (f32x4){lf[0], lf[1], lf[2], lf[3]};
  *(f32x4*)(L.LF + t * 128 + d0 + 4) = (f32x4){lf[4], lf[5], lf[6], lf[7]};
}
DI void prep_stepC(const PrepSlot& L, bf16x8 vcur, int t, int d0, const float (&sq)[8], const float (&kk)[8]) {
  f32x4 b0 = *(f32x4*)(L.LF + t * 128 + d0), b1 = *(f32x4*)(L.LF + t * 128 + d0 + 4);
  f32x4 m0 = *(f32x4*)(L.LF + 15 * 128 + d0), m1 = *(f32x4*)(L.LF + 15 * 128 + d0 + 4);
  f32x4 em0 = *(f32x4*)(L.EM + d0), em1 = *(f32x4*)(L.EM + d0 + 4);
  f32x4 el0 = *(f32x4*)(L.ELM + d0), el1 = *(f32x4*)(L.ELM + d0 + 4);
  float qi[8], qt[8], kt[8], ko[8];
#pragma unroll
  for (int i = 0; i < 8; ++i) {
    const float b = (i < 4) ? b0[i & 3] : b1[i & 3];
    const float bm = (i < 4) ? m0[i & 3] : m1[i & 3];
    const float em = (i < 4) ? em0[i & 3] : em1[i & 3];
    const float el = (i < 4) ? el0[i & 3] : el1[i & 3];
    qt[i] = sq[i] * __builtin_amdgcn_exp2f(b - bm);
    kt[i] = kk[i] * __builtin_amdgcn_exp2f(bm - b);
    qi[i] = qt[i] * em;
    ko[i] = kt[i] * el;
  }
  uint4 o;
  o.x = pk2(ko[0], ko[1]); o.y = pk2(ko[2], ko[3]); o.z = pk2(ko[4], ko[5]); o.w = pk2(ko[6], ko[7]);
  *(uint4*)(L.KoT + t * 136 + d0) = o;
  *(bf16x8*)(L.VT + t * 136 + d0) = vcur;
  o.x = pk2(qi[0], qi[1]); o.y = pk2(qi[2], qi[3]); o.z = pk2(qi[4], qi[5]); o.w = pk2(qi[6], qi[7]);
  *(uint4*)(L.Qin + t * 136 + d0) = o;
  o.x = pk2(qt[0], qt[1]); o.y = pk2(qt[2], qt[3]); o.z = pk2(qt[4], qt[5]); o.w = pk2(qt[6], qt[7]);
  *(uint4*)(L.Qt + t * 136 + d0) = o;
  o.x = pk2(kt[0], kt[1]); o.y = pk2(kt[2], kt[3]); o.z = pk2(kt[4], kt[5]); o.w = pk2(kt[6], kt[7]);
  *(uint4*)(L.Kt + t * 136 + d0) = o;
}
DI void prep_copyout(const PrepSlot& L, unsigned char* rec, int tid, int wave, int lane, int c, int hh) {
  const int f = wave, fd = f >> 1, fk = f & 1;
  {
    const bf16_t* s0 = L.Qin + c * 136 + 32 * fd + 16 * fk + 4 * hh;
    uint2 x0 = *(const uint2*)s0, x1 = *(const uint2*)(s0 + 8);
    st16_wt(rec + REC_QF + (f * 64 + lane) * 16, make_uint4(x0.x, x0.y, x1.x, x1.y));
  }
  {
    const bf16_t* k0 = L.KoT + (16 * fk + 4 * hh) * 136 + 32 * fd + c;
    const bf16_t* v0 = L.VT + (16 * fk + 4 * hh) * 136 + 32 * fd + c;
    uint4 ok, ov;
    ok.x = (unsigned)k0[0 * 136] | ((unsigned)k0[1 * 136] << 16); ok.y = (unsigned)k0[2 * 136] | ((unsigned)k0[3 * 136] << 16);
    ok.z = (unsigned)k0[8 * 136] | ((unsigned)k0[9 * 136] << 16); ok.w = (unsigned)k0[10 * 136] | ((unsigned)k0[11 * 136] << 16);
    ov.x = (unsigned)v0[0 * 136] | ((unsigned)v0[1 * 136] << 16); ov.y = (unsigned)v0[2 * 136] | ((unsigned)v0[3 * 136] << 16);
    ov.z = (unsigned)v0[8 * 136] | ((unsigned)v0[9 * 136] << 16); ov.w = (unsigned)v0[10 * 136] | ((unsigned)v0[11 * 136] << 16);
    st16_wt(rec + REC_KF + (f * 64 + lane) * 16, ok);
    st16_wt(rec + REC_VF + (f * 64 + lane) * 16, ov);
  }
  if (tid < 32) *(f32x4*)(rec + REC_AL + tid * 16) = *(const f32x4*)(L.AL + tid * 4);
}
DI void prep_intra(const PrepSlot& L, unsigned char* rec, int lane, int c, int hh) {
  f32x16 at;
#pragma unroll
  for (int q = 0; q < 16; ++q) at[q] = 0.f;
#pragma unroll
  for (int ks = 0; ks < 8; ++ks) {
    bf16x8 a = *(const bf16x8*)(L.Kt + c * 136 + ks * 16 + hh * 8);
    bf16x8 b = *(const bf16x8*)(L.Qt + c * 136 + ks * 16 + hh * 8);
    at = mfma32(a, b, at);
  }
#pragma unroll
  for (int q = 0; q < 16; ++q) {
    int sr = 8 * (q >> 2) + 4 * hh + (q & 3);
    if (sr > c) at[q] = 0.f;
  }
  st16_wt(rec + REC_PF + lane * 16, __builtin_bit_cast(uint4, pack8(at, 0)));
  st16_wt(rec + REC_PF + (64 + lane) * 16, __builtin_bit_cast(uint4, pack8(at, 1)));
}
DI void scan_prep(PP p, int j, unsigned char* smem) {
  const int tid = threadIdx.x, wave = tid >> 6, lane = tid & 63, c = lane & 31, hh = lane >> 5;
  const PrepSlot L0 = prep_slot(smem, 0), L1 = prep_slot(smem, 1);
  const int t = tid >> 4, d0 = (tid & 15) * 8;
  const int G = gridDim.x;
  int pr = blockIdx.x;
  if (pr >= 1536) return;
  PrepRegs R0, R1;
  prep_load(p, j, 2 * pr, t, d0, R0); prep_load(p, j, 2 * pr + 1, t, d0, R1);
  for (; pr < 1536; pr += G) {
    float sq0[8], kk0[8], sq1[8], kk1[8];
    const bf16x8 v0 = R0.v8, v1 = R1.v8;
    prep_stepA(L0, R0, t, d0, sq0, kk0);
    prep_stepA(L1, R1, t, d0, sq1, kk1);
    if (pr + G < 1536) { prep_load(p, j, 2 * (pr + G), t, d0, R0); prep_load(p, j, 2 * (pr + G) + 1, t, d0, R1); }
    lds_barrier();
    if (tid < 256) {
      const PrepSlot& L = (tid < 128) ? L0 : L1;
      const int d = tid & 127;
      float run = 0.f, bmid = 0.f;
#pragma unroll
      for (int tt = 0; tt < 32; ++tt) { run += L.LF[tt * 128 + d]; L.LF[tt * 128 + d] = run; if (tt == 15) bmid = run; }
      L.AL[d] = __builtin_amdgcn_exp2f(run);
      L.EM[d] = __builtin_amdgcn_exp2f(bmid);
      L.ELM[d] = __builtin_amdgcn_exp2f(run - bmid);
    }
    lds_barrier();
    prep_stepC(L0, v0, t, d0, sq0, kk0);
    prep_stepC(L1, v1, t, d0, sq1, kk1);
    lds_barrier();
    unsigned char* rec0 = rec_ptr(p, 2 * pr);
    unsigned char* rec1 = rec_ptr(p, 2 * pr + 1);
    prep_copyout(L0, rec0, tid, wave, lane, c, hh);
    prep_copyout(L1, rec1, tid, wave, lane, c, hh);
    if (wave == 0) prep_intra(L0, rec0, lane, c, hh);
    else if (wave == 1) prep_intra(L1, rec1, lane, c, hh);
    lds_barrier();
  }
}

DI void scan_chain_item(PP p, int j, int item, unsigned char* smem) {
  int s, hd, dir;
  if (item < 64) { s = 16 + (item >> 3); hd = (item >> 1) & 3; dir = item & 1; }
  else { int it = item - 64; s = it >> 3; hd = (it >> 1) & 3; dir = it & 1; }
  const int L = (s < 16) ? 256 : 1024;
  const int row0 = (s < 16) ? s * 256 : NCTX + (s - 16) * 1024;
  const int tid = threadIdx.x, wave = tid >> 6, lane = tid & 63, c = lane & 31, hh = lane >> 5;
  const int nch = L / 32, ck0 = row0 / 32;
  bf16_t* obuf = (bf16_t*)p->oproj + (dir ? (size_t)NTOK * 512 : 0);
#define REC_OF(n) rec_ptr(p, (((ck0 + (dir ? nch - 1 - (n) : (n))) * 4 + hd) * 2 + dir))
  if (wave >= 4) {
    const int lt = tid - 256;
    uint4 g0, g1, g2, g3, g4, g5, g6;
#define RG_LOAD(srcp) do { const unsigned char* s_ = (srcp) + lt * 16; g0 = *(const uint4*)(s_); g1 = *(const uint4*)(s_ + 4096); g2 = *(const uint4*)(s_ + 8192); \
    g3 = *(const uint4*)(s_ + 12288); g4 = *(const uint4*)(s_ + 16384); g5 = *(const uint4*)(s_ + 20480); g6 = *(const uint4*)(s_ + 24576); } while (0)
#define RG_STORE(dstp) do { unsigned char* d_ = (dstp) + lt * 16; *(uint4*)(d_) = g0; *(uint4*)(d_ + 4096) = g1; *(uint4*)(d_ + 8192) = g2; \
    *(uint4*)(d_ + 12288) = g3; *(uint4*)(d_ + 16384) = g4; *(uint4*)(d_ + 20480) = g5; *(uint4*)(d_ + 24576) = g6; } while (0)
    RG_LOAD(REC_OF(0));
    RG_STORE(smem);
    if (nch > 1) RG_LOAD(REC_OF(1));
    lds_barrier();
    for (int n = 0; n < nch; ++n) {
      if (n + 1 < nch) {
        RG_STORE(smem + ((n + 1) & 1) * REC_BYTES);
        if (n + 2 < nch) RG_LOAD(REC_OF(n + 2));
      }
      lds_barrier();
    }
#undef RG_LOAD
#undef RG_STORE
  } else {
    const int vs = wave;
    __builtin_amdgcn_s_setprio(3);
    f32x16 S[4];
    if (s >= 16) {
      const float* sp = p->state + ((((size_t)(s - 16) * 2 + j) * 2 + dir) * 4 + hd) * 16384;
#pragma unroll
      for (int dt = 0; dt < 4; ++dt)
#pragma unroll
        for (int q = 0; q < 16; ++q) {
          int d = 32 * dt + 8 * (q >> 2) + 4 * hh + (q & 3);
          S[dt][q] = sp[d * 128 + vs * 32 + c];
        }
    } else {
#pragma unroll
      for (int dt = 0; dt < 4; ++dt)
#pragma unroll
        for (int q = 0; q < 16; ++q) S[dt][q] = 0.f;
    }
    lds_barrier();
    for (int n = 0; n < nch; ++n) {
      const unsigned char* rb = smem + (n & 1) * REC_BYTES;
      bf16x8 qf[8];
      const bf16x8 vf0 = *(const bf16x8*)(rb + REC_VF + ((vs * 2 + 0) * 64 + lane) * 16);
      const bf16x8 vf1 = *(const bf16x8*)(rb + REC_VF + ((vs * 2 + 1) * 64 + lane) * 16);
      const bf16x8 pf0 = *(const bf16x8*)(rb + REC_PF + lane * 16);
      const bf16x8 pf1 = *(const bf16x8*)(rb + REC_PF + (64 + lane) * 16);
#pragma unroll
      for (int f = 0; f < 8; ++f) qf[f] = *(const bf16x8*)(rb + REC_QF + (f * 64 + lane) * 16);
      __builtin_amdgcn_sched_barrier(0);
      f32x16 o;
#pragma unroll
      for (int q = 0; q < 16; ++q) o[q] = 0.f;
      o = mfma32(pf0, vf0, o);
      o = mfma32(pf1, vf1, o);
#pragma unroll
      for (int f = 0; f < 8; ++f) o = mfma32(qf[f], pack8(S[f >> 1], f & 1), o);
      __builtin_amdgcn_sched_barrier(0);
      {
        const int ck = ck0 + (dir ? nch - 1 - n : n);
#pragma unroll
        for (int q = 0; q < 16; ++q) {
          const int tr = 8 * (q >> 2) + 4 * hh + (q & 3);
          const int row = ck * 32 + (dir ? 31 - tr : tr);
          obuf[(size_t)row * 512 + hd * 128 + vs * 32 + c] = (bf16_t)pk2(o[q], 0.f);
        }
      }
#pragma unroll
      for (int half = 0; half < 2; ++half) {
        bf16x8 kf[4];
        f32x4 al[8];
#pragma unroll
        for (int f = 0; f < 4; ++f) kf[f] = *(const bf16x8*)(rb + REC_KF + ((half * 4 + f) * 64 + lane) * 16);
#pragma unroll
        for (int d2 = 0; d2 < 2; ++d2)
#pragma unroll
          for (int g = 0; g < 4; ++g) al[d2 * 4 + g] = *(const f32x4*)(rb + REC_AL + (32 * (half * 2 + d2) + 8 * g + 4 * hh) * 4);
        __builtin_amdgcn_sched_barrier(0);
#pragma unroll
        for (int d2 = 0; d2 < 2; ++d2) {
          const int dt = half * 2 + d2;
#pragma unroll
          for (int g = 0; g < 4; ++g) {
            const f32x4 a4 = al[d2 * 4 + g];
            S[dt][4 * g + 0] *= a4[0]; S[dt][4 * g + 1] *= a4[1]; S[dt][4 * g + 2] *= a4[2]; S[dt][4 * g + 3] *= a4[3];
          }
          S[dt] = mfma32(kf[d2 * 2 + 0], vf0, S[dt]);
          S[dt] = mfma32(kf[d2 * 2 + 1], vf1, S[dt]);
        }
        __builtin_amdgcn_sched_barrier(0);
      }
      lds_barrier();
    }
    __builtin_amdgcn_s_setprio(0);
    if (s < 16) {
      float* op = p->out + (size_t)NTOK * DM + ((((size_t)s * 2 + j) * 2 + dir) * 4 + hd) * 16384;
#pragma unroll
      for (int dt = 0; dt < 4; ++dt)
#pragma unroll
        for (int q = 0; q < 16; ++q) {
          int d = 32 * dt + 8 * (q >> 2) + 4 * hh + (q & 3);
          op[d * 128 + vs * 32 + c] = S[dt][q];
        }
    }
  }
#undef REC_OF
  __syncthreads();
}

constexpr int R64_BYTES = 57344, R64_QF = 0, R64_KF = 16384, R64_VF = 32768, R64_PF = 49152, R64_AL = 55296;
constexpr int N_R64_A = 438;
DI unsigned char* rec64_ptr(PP p, int it) {
  if (it < N_R64_A) return (unsigned char*)p->oproj + (size_t)NTOK * 512 * 4 + (size_t)it * R64_BYTES;
  if (it < 2 * N_R64_A) return (unsigned char*)p->out + (size_t)NTOK * DM * 2 + (size_t)(it - N_R64_A) * R64_BYTES;
  return (unsigned char*)p->Kc + (size_t)(it - 2 * N_R64_A) * R64_BYTES;
}
struct Prep64 { float* LF; bf16_t *Qin, *Qt, *Kt, *Ko, *Vr; float *AL, *EM, *ELM; };
DI void prep64_load(PP p, int j, int item, int t, int d0, PrepRegs& R) {
  const int dir = item & 1, hd = (item >> 1) & 3, ck = item >> 3;
  const bf16_t* zr = p->z + (size_t)(ck * 64 + (dir ? 63 - t : t)) * ZN_REC + hd * 128 + d0;
  R.q8 = *(const bf16x8*)(zr + 1024); R.f8 = *(const bf16x8*)(zr + (dir ? 2048 : 1536)); R.v8 = *(const bf16x8*)(zr + 2560);
  const float* lp = p->lb + (j * 2 + dir) * 512 + hd * 128 + d0;
  R.lwa = *(const f32x4*)lp; R.lwb = *(const f32x4*)(lp + 4);
}
DI void prep64_stepA(const Prep64& L, const PrepRegs& R, int t, int d0, float (&sq)[8], float (&kk)[8]) {
  float lf[8];
#pragma unroll
  for (int i = 0; i < 8; ++i) {
    const float lw = (i < 4) ? R.lwa[i & 3] : R.lwb[i & 3];
    const float zf = bfs(R.f8[i]);
    const float sg = __builtin_amdgcn_rcpf(1.f + __builtin_amdgcn_exp2f(-1.4426950408889634f * zf));
    float f = lw + (1.f - lw) * sg;
    f = fminf(fmaxf(f, 1e-6f), 1.f);
    lf[i] = __builtin_amdgcn_logf(f);
    kk[i] = 1.f - f;
    sq[i] = silu_f(bfs(R.q8[i]));
  }
  *(f32x4*)(L.LF + t * 128 + d0) = (f32x4){lf[0], lf[1], lf[2], lf[3]};
  *(f32x4*)(L.LF + t * 128 + d0 + 4) = (f32x4){lf[4], lf[5], lf[6], lf[7]};
}
DI void prep64_stepC(const Prep64& L, bf16x8 vcur, int t, int d0, const float (&sq)[8], const float (&kk)[8]) {
  f32x4 b0 = *(f32x4*)(L.LF + t * 128 + d0), b1 = *(f32x4*)(L.LF + t * 128 + d0 + 4);
  f32x4 m0 = *(f32x4*)(L.LF + 31 * 128 + d0), m1 = *(f32x4*)(L.LF + 31 * 128 + d0 + 4);
  f32x4 em0 = *(f32x4*)(L.EM + d0), em1 = *(f32x4*)(L.EM + d0 + 4);
  f32x4 el0 = *(f32x4*)(L.ELM + d0), el1 = *(f32x4*)(L.ELM + d0 + 4);
  float qi[8], qt[8], kt[8], ko[8];
#pragma unroll
  for (int i = 0; i < 8; ++i) {
    const float b = (i < 4) ? b0[i & 3] : b1[i & 3];
    const float bm = (i < 4) ? m0[i & 3] : m1[i & 3];
    const float em = (i < 4) ? em0[i & 3] : em1[i & 3];
    const float el = (i < 4) ? el0[i & 3] : el1[i & 3];
    qt[i] = sq[i] * __builtin_amdgcn_exp2f(b - bm);
    kt[i] = kk[i] * __builtin_amdgcn_exp2f(bm - b);
    qi[i] = qt[i] * em;
    ko[i] = kt[i] * el;
  }
  uint4 o;
  o.x = pk2(qi[0], qi[1]); o.y = pk2(qi[2], qi[3]); o.z = pk2(qi[4], qi[5]); o.w = pk2(qi[6], qi[7]);
  *(uint4*)(L.Qin + t * 136 + d0) = o;
  o.x = pk2(qt[0], qt[1]); o.y = pk2(qt[2], qt[3]); o.z = pk2(qt[4], qt[5]); o.w = pk2(qt[6], qt[7]);
  *(uint4*)(L.Qt + t * 136 + d0) = o;
  o.x = pk2(kt[0], kt[1]); o.y = pk2(kt[2], kt[3]); o.z = pk2(kt[4], kt[5]); o.w = pk2(kt[6], kt[7]);
  *(uint4*)(L.Kt + t * 136 + d0) = o;
  o.x = pk2(ko[0], ko[1]); o.y = pk2(ko[2], ko[3]); o.z = pk2(ko[4], ko[5]); o.w = pk2(ko[6], ko[7]);
  *(uint4*)(L.Ko + t * 136 + d0) = o;
  *(bf16x8*)(L.Vr + t * 136 + d0) = vcur;
}
DI void scan_prep64(PP p, int j, unsigned char* smem, int item, int step, int item_end) {
  const int tid = threadIdx.x, wave = tid >> 6, lane = tid & 63, c = lane & 31, hh = lane >> 5;
  Prep64 L;
  L.LF = (float*)smem;
  L.Qin = (bf16_t*)(smem + 32768);
  L.Qt = L.Qin + 64 * 136; L.Kt = L.Qt + 64 * 136; L.Ko = L.Kt + 64 * 136; L.Vr = L.Ko + 64 * 136;
  L.AL = (float*)(L.Vr + 64 * 136); L.EM = L.AL + 128; L.ELM = L.EM + 128;
  const int t0 = tid >> 4, t1 = t0 + 32, d0 = (tid & 15) * 8;
  const int G = gridDim.x;
  if (item >= item_end) return;
  PrepRegs R0, R1;
  prep64_load(p, j, item, t0, d0, R0); prep64_load(p, j, item, t1, d0, R1);
  for (; item < item_end; item += step) {
    float sq0[8], kk0[8], sq1[8], kk1[8];
    const bf16x8 v0 = R0.v8, v1 = R1.v8;
    prep64_stepA(L, R0, t0, d0, sq0, kk0);
    prep64_stepA(L, R1, t1, d0, sq1, kk1);
    if (item + step < item_end) { prep64_load(p, j, item + step, t0, d0, R0); prep64_load(p, j, item + step, t1, d0, R1); }
    lds_barrier();
    if (tid < 128) {
      float run = 0.f, bmid = 0.f;
#pragma unroll
      for (int tt = 0; tt < 64; ++tt) { run += L.LF[tt * 128 + tid]; L.LF[tt * 128 + tid] = run; if (tt == 31) bmid = run; }
      L.AL[tid] = __builtin_amdgcn_exp2f(run);
      L.EM[tid] = __builtin_amdgcn_exp2f(bmid);
      L.ELM[tid] = __builtin_amdgcn_exp2f(run - bmid);
    }
    lds_barrier();
    prep64_stepC(L, v0, t0, d0, sq0, kk0);
    prep64_stepC(L, v1, t1, d0, sq1, kk1);
    lds_barrier();
    unsigned char* rec = rec64_ptr(p, item);
#pragma unroll
    for (int e = 0; e < 2; ++e) {
      const int f = wave * 2 + e;
      {
        const int mT = f >> 3, dt = (f >> 1) & 3, k2 = f & 1;
        const bf16_t* s0 = L.Qin + (32 * mT + c) * 136 + 32 * dt + 16 * k2 + 4 * hh;
        uint2 x0 = *(const uint2*)s0, x1 = *(const uint2*)(s0 + 8);
        st16_wt(rec + R64_QF + (f * 64 + lane) * 16, make_uint4(x0.x, x0.y, x1.x, x1.y));
      }
      {
        const int fd = f >> 2, ks = f & 3;
        const bf16_t* k0 = L.Ko + (16 * ks + 4 * hh) * 136 + 32 * fd + c;
        const bf16_t* w0 = L.Vr + (16 * ks + 4 * hh) * 136 + 32 * fd + c;
        uint4 ok, ov;
        ok.x = (unsigned)k0[0 * 136] | ((unsigned)k0[1 * 136] << 16); ok.y = (unsigned)k0[2 * 136] | ((unsigned)k0[3 * 136] << 16);
        ok.z = (unsigned)k0[8 * 136] | ((unsigned)k0[9 * 136] << 16); ok.w = (unsigned)k0[10 * 136] | ((unsigned)k0[11 * 136] << 16);
        ov.x = (unsigned)w0[0 * 136] | ((unsigned)w0[1 * 136] << 16); ov.y = (unsigned)w0[2 * 136] | ((unsigned)w0[3 * 136] << 16);
        ov.z = (unsigned)w0[8 * 136] | ((unsigned)w0[9 * 136] << 16); ov.w = (unsigned)w0[10 * 136] | ((unsigned)w0[11 * 136] << 16);
        st16_wt(rec + R64_KF + (f * 64 + lane) * 16, ok);
        st16_wt(rec + R64_VF + (f * 64 + lane) * 16, ov);
      }
    }
    if (tid < 32) *(f32x4*)(rec + R64_AL + tid * 16) = *(const f32x4*)(L.AL + tid * 4);
    if (wave < 3) {
      const int sT = (wave == 2) ? 1 : 0, tT = (wave == 0) ? 0 : 1;
      f32x16 at;
#pragma unroll
      for (int q = 0; q < 16; ++q) at[q] = 0.f;
#pragma unroll
      for (int ks = 0; ks < 8; ++ks) {
        bf16x8 a = *(const bf16x8*)(L.Kt + (32 * sT + c) * 136 + ks * 16 + hh * 8);
        bf16x8 b = *(const bf16x8*)(L.Qt + (32 * tT + c) * 136 + ks * 16 + hh * 8);
        at = mfma32(a, b, at);
      }
      if (sT == tT) {
#pragma unroll
        for (int q = 0; q < 16; ++q) {
          int sr = 8 * (q >> 2) + 4 * hh + (q & 3);
          if (sr > c) at[q] = 0.f;
        }
      }
      st16_wt(rec + R64_PF + ((wave * 2 + 0) * 64 + lane) * 16, __builtin_bit_cast(uint4, pack8(at, 0)));
      st16_wt(rec + R64_PF + ((wave * 2 + 1) * 64 + lane) * 16, __builtin_bit_cast(uint4, pack8(at, 1)));
    }
    lds_barrier();
  }
}

DI void scan_chain_item64(PP p, int j, int item, unsigned char* smem) {
  int s, hd, dir;
  if (item < 64) { s = 16 + (item >> 3); hd = (item >> 1) & 3; dir = item & 1; }
  else { int it = item - 64; s = it >> 3; hd = (it >> 1) & 3; dir = it & 1; }
  const int L = (s < 16) ? 256 : 1024;
  const int row0 = (s < 16) ? s * 256 : NCTX + (s - 16) * 1024;
  const int tid = threadIdx.x, wave = tid >> 6, lane = tid & 63, c = lane & 31, hh = lane >> 5;
  const int nch = L / 64, ck0 = row0 / 64;
  bf16_t* obuf = (bf16_t*)p->oproj + (dir ? (size_t)NTOK * 512 : 0);
#define REC_OF(n) rec64_ptr(p, (((ck0 + (dir ? nch - 1 - (n) : (n))) * 4 + hd) * 2 + dir))
  if (wave >= 4) {
    const int lt = tid - 256;
    uint4 g0, g1, g2, g3, g4, g5, g6, g7, g8, g9, g10, g11, g12, g13;
#define RG_LOAD(srcp) do { const unsigned char* s_ = (srcp) + lt * 16; g0 = *(const uint4*)(s_); g1 = *(const uint4*)(s_ + 4096); g2 = *(const uint4*)(s_ + 8192); \
    g3 = *(const uint4*)(s_ + 12288); g4 = *(const uint4*)(s_ + 16384); g5 = *(const uint4*)(s_ + 20480); g6 = *(const uint4*)(s_ + 24576); \
    g7 = *(const uint4*)(s_ + 28672); g8 = *(const uint4*)(s_ + 32768); g9 = *(const uint4*)(s_ + 36864); g10 = *(const uint4*)(s_ + 40960); \
    g11 = *(const uint4*)(s_ + 45056); g12 = *(const uint4*)(s_ + 49152); g13 = *(const uint4*)(s_ + 53248); } while (0)
#define RG_STORE(dstp) do { unsigned char* d_ = (dstp) + lt * 16; *(uint4*)(d_) = g0; *(uint4*)(d_ + 4096) = g1; *(uint4*)(d_ + 8192) = g2; \
    *(uint4*)(d_ + 12288) = g3; *(uint4*)(d_ + 16384) = g4; *(uint4*)(d_ + 20480) = g5; *(uint4*)(d_ + 24576) = g6; \
    *(uint4*)(d_ + 28672) = g7; *(uint4*)(d_ + 32768) = g8; *(uint4*)(d_ + 36864) = g9; *(uint4*)(d_ + 40960) = g10; \
    *(uint4*)(d_ + 45056) = g11; *(uint4*)(d_ + 49152) = g12; *(uint4*)(d_ + 53248) = g13; } while (0)
    RG_LOAD(REC_OF(0));
    RG_STORE(smem);
    if (nch > 1) RG_LOAD(REC_OF(1));
    lds_barrier();
    for (int n = 0; n < nch; ++n) {
      if (n + 1 < nch) {
        RG_STORE(smem + ((n + 1) & 1) * R64_BYTES);
        if (n + 2 < nch) RG_LOAD(REC_OF(n + 2));
      }
      lds_barrier();
    }
#undef RG_LOAD
#undef RG_STORE
  } else {
    const int vs = wave;
    f32x16 S[4];
    if (s >= 16) {
      const float* sp = p->state + ((((size_t)(s - 16) * 2 + j) * 2 + dir) * 4 + hd) * 16384;
#pragma unroll
      for (int dt = 0; dt < 4; ++dt)
        {
#pragma unroll
          for (int q = 0; q < 16; ++q) {
            int d = 32 * dt + 8 * (q >> 2) + 4 * hh + (q & 3);
            S[dt][q] = sp[d * 128 + vs * 32 + c];
          }
          __builtin_amdgcn_sched_barrier(0);
        }
    } else {
#pragma unroll
      for (int dt = 0; dt < 4; ++dt)
#pragma unroll
        for (int q = 0; q < 16; ++q) S[dt][q] = 0.f;
    }
    lds_barrier();
    for (int n = 0; n < nch; ++n) {
      const unsigned char* rb = smem + (n & 1) * R64_BYTES;
      const int ck = ck0 + (dir ? nch - 1 - n : n);
      bf16x8 vf[4], sp8[8];
#pragma unroll
      for (int ks = 0; ks < 4; ++ks) vf[ks] = *(const bf16x8*)(rb + R64_VF + ((vs * 4 + ks) * 64 + lane) * 16);
#pragma unroll
      for (int f = 0; f < 8; ++f) sp8[f] = pack8(S[f >> 1], f & 1);
#pragma unroll
      for (int mT = 0; mT < 2; ++mT) {
        bf16x8 qf[8], pf[4];
#pragma unroll
        for (int f = 0; f < 8; ++f) qf[f] = *(const bf16x8*)(rb + R64_QF + ((mT * 8 + f) * 64 + lane) * 16);
        if (mT == 0) {
          pf[0] = *(const bf16x8*)(rb + R64_PF + (0 * 64 + lane) * 16); pf[1] = *(const bf16x8*)(rb + R64_PF + (1 * 64 + lane) * 16);
        } else {
          pf[0] = *(const bf16x8*)(rb + R64_PF + (2 * 64 + lane) * 16); pf[1] = *(const bf16x8*)(rb + R64_PF + (3 * 64 + lane) * 16);
          pf[2] = *(const bf16x8*)(rb + R64_PF + (4 * 64 + lane) * 16); pf[3] = *(const bf16x8*)(rb + R64_PF + (5 * 64 + lane) * 16);
        }
        __builtin_amdgcn_sched_barrier(0);
        f32x16 o;
#pragma unroll
        for (int q = 0; q < 16; ++q) o[q] = 0.f;
        o = mfma32(pf[0], vf[0], o);
        o = mfma32(pf[1], vf[1], o);
        if (mT == 1) { o = mfma32(pf[2], vf[2], o); o = mfma32(pf[3], vf[3], o); }
#pragma unroll
        for (int f = 0; f < 8; ++f) o = mfma32(qf[f], sp8[f], o);
        __builtin_amdgcn_sched_barrier(0);
#pragma unroll
        for (int q = 0; q < 16; ++q) {
          const int tr = 32 * mT + 8 * (q >> 2) + 4 * hh + (q & 3);
          const int row = ck * 64 + (dir ? 63 - tr : tr);
          obuf[(size_t)row * 512 + hd * 128 + vs * 32 + c] = (bf16_t)pk2(o[q], 0.f);
        }
      }
#pragma unroll
      for (int dt = 0; dt < 4; ++dt) {
        bf16x8 kf[4];
        f32x4 al[4];
#pragma unroll
        for (int ks = 0; ks < 4; ++ks) kf[ks] = *(const bf16x8*)(rb + R64_KF + ((dt * 4 + ks) * 64 + lane) * 16);
#pragma unroll
        for (int g = 0; g < 4; ++g) al[g] = *(const f32x4*)(rb + R64_AL + (32 * dt + 8 * g + 4 * hh) * 4);
#pragma unroll
        for (int g = 0; g < 4; ++g) {
          S[dt][4 * g + 0] *= al[g][0]; S[dt][4 * g + 1] *= al[g][1]; S[dt][4 * g + 2] *= al[g][2]; S[dt][4 * g + 3] *= al[g][3];
        }
#pragma unroll
        for (int ks = 0; ks < 4; ++ks) S[dt] = mfma32(kf[ks], vf[ks], S[dt]);
      }
      lds_barrier();
    }
    if (s < 16) {
      int lz = 0; asm volatile("" : "+v"(lz));
      float* op = p->out + (size_t)NTOK * DM + ((((size_t)s * 2 + j) * 2 + dir) * 4 + hd) * 16384;
#pragma unroll
      for (int dt = 0; dt < 4; ++dt)
        {
#pragma unroll
          for (int q = 0; q < 16; ++q) {
            int d = 32 * dt + 8 * (q >> 2) + 4 * hh + (q & 3);
            op[d * 128 + vs * 32 + c + lz] = S[dt][q];
          }
          __builtin_amdgcn_sched_barrier(0);
        }
    }
  }
#undef REC_OF
  __syncthreads();
}

DI void pool_job(PP p, int job, unsigned char* smem) {
  bf16_t* T = (bf16_t*)smem;
  bf16_t* Gt = T + 32 * 512;
  const int tid = threadIdx.x, cp = tid & 255, tsub = tid >> 8;
  const int g = cp >> 6, half = 1 << g;
  const int rowb = job * 16;
  const int L = (rowb < NCTX) ? 256 : 1024;
  const int seq0 = (rowb < NCTX) ? (rowb & ~255) : NCTX + ((rowb - NCTX) & ~1023);
  const int tb = rowb - seq0;
#pragma unroll
  for (int i = 0; i < 4; ++i) {
    const int e = tid + NTHR * i, r = e >> 6, c16 = e & 63, t = tb - 8 + r;
    if (t >= 0 && t < L) *(uint4*)(T + r * 512 + c16 * 8) = *(const uint4*)(p->z + (size_t)(seq0 + t) * ZN_REC + c16 * 8);
  }
#pragma unroll
  for (int i = 0; i < 2; ++i) {
    const int e = tid + NTHR * i, r = e >> 6, c16 = e & 63;
    *(uint4*)(Gt + r * 512 + c16 * 8) = *(const uint4*)(p->z + (size_t)(rowb + r) * ZN_REC + 512 + c16 * 8);
  }
  __syncthreads();
  {
    const int tl0 = tsub * 8, t0 = tb + tl0;
    int lo = max(t0 - half, 0), hi = min(t0 + half, L);
    float s0 = 0.f, s1 = 0.f;
    for (int sidx = lo; sidx < hi; ++sidx) {
      unsigned u = *(const unsigned*)(T + (sidx - tb + 8) * 512 + 2 * cp);
      s0 += __uint_as_float(u << 16); s1 += __uint_as_float(u & 0xffff0000u);
    }
#pragma unroll
    for (int i = 0; i < 8; ++i) {
      const int tl = tl0 + i, t = tb + tl, row = rowb + tl;
      const float inv = __builtin_amdgcn_rcpf((float)(hi - lo));
      const unsigned us = *(const unsigned*)(T + (tl + 8) * 512 + 2 * cp);
      const unsigned ug = *(const unsigned*)(Gt + tl * 512 + 2 * cp);
      const float y0 = (s0 * inv - __uint_as_float(us << 16)) * silu_f(__uint_as_float(ug << 16));
      const float y1 = (s1 * inv - __uint_as_float(us & 0xffff0000u)) * silu_f(__uint_as_float(ug & 0xffff0000u));
      *(unsigned*)(p->r + (size_t)row * DM + 2 * cp) = pk2(y0, y1);
      if (t + half < L) { const unsigned u = *(const unsigned*)(T + (tl + half + 8) * 512 + 2 * cp); s0 += __uint_as_float(u << 16); s1 += __uint_as_float(u & 0xffff0000u); ++hi; }
      if (t - half >= 0) { const unsigned u = *(const unsigned*)(T + (tl - half + 8) * 512 + 2 * cp); s0 -= __uint_as_float(u << 16); s1 -= __uint_as_float(u & 0xffff0000u); ++lo; }
    }
  }
  __syncthreads();
}

DI void phase_rec_in(PP p, int j, unsigned char* smem) {
  const int G = gridDim.x, c = blockIdx.x;
  EpiBf16 E{p->z, ZN_REC};
  RecOrder S{0, (G == 256) ? 512 : 672, G, c};
  phase_gemm_s(p->h, p->WrecT + (size_t)j * ZN_REC * 1024, E, S, smem);
}
DI void phase_scan(PP p, int j, unsigned char* smem) {
  const int G = gridDim.x, c = blockIdx.x;
  if (G == 256) {
    EpiBf16 E{p->z, ZN_REC};
    RecOrder S{512, 672, G, c};
    phase_gemm_s(p->h, p->WrecT + (size_t)j * ZN_REC * 1024, E, S, smem);
    if (c < 160) scan_prep64(p, j, smem, 3 * c, 1, 3 * c + 3);
    else scan_prep64(p, j, smem, 480 + (c - 160) * 11, 1, 480 + (c - 160) * 11 + 11);
  } else {
    scan_prep64(p, j, smem, c, G, 1536);
  }
}
DI void phase_chain(PP p, int j, unsigned char* smem) {
  const int b = blockIdx.x, G = gridDim.x;
  for (int item = b; item < 192; item += G) scan_chain_item64(p, j, item, smem);
  if (G > 64) { if (b >= 64) for (int pj = b - 64; pj < NTOK / 16; pj += G - 64) pool_job(p, pj, smem); }
  else for (int pj = b; pj < NTOK / 16; pj += G) pool_job(p, pj, smem);
}

DI void phase_combine(PP p, int j) {
  const int wave = threadIdx.x >> 6, lane = threadIdx.x & 63;
  const bf16_t* of = (const bf16_t*)p->oproj;
  const bf16_t* ob = of + (size_t)NTOK * 512;
  const float2 hn = *(const float2*)(p->rec_head_norm + j * 128 + 2 * lane);
  for (int pi = blockIdx.x * 8 + wave; pi < NTOK / 2; pi += gridDim.x * 8) {
    unsigned ua[2][4], ub[2][4], ug[2][4], res[2][4];
#pragma unroll
    for (int r = 0; r < 2; ++r)
#pragma unroll
      for (int hd = 0; hd < 4; ++hd) {
        const int row = 2 * pi + r, col = hd * 128 + 2 * lane;
        ua[r][hd] = *(const unsigned*)(of + (size_t)row * 512 + col);
        ub[r][hd] = *(const unsigned*)(ob + (size_t)row * 512 + col);
        ug[r][hd] = *(const unsigned*)(p->z + (size_t)row * ZN_REC + 3072 + col);
      }
    float o0[2][4], o1[2][4], ss[2][4];
#pragma unroll
    for (int r = 0; r < 2; ++r)
#pragma unroll
      for (int hd = 0; hd < 4; ++hd) {
        o0[r][hd] = __uint_as_float(ua[r][hd] << 16) + __uint_as_float(ub[r][hd] << 16);
        o1[r][hd] = __uint_as_float(ua[r][hd] & 0xffff0000u) + __uint_as_float(ub[r][hd] & 0xffff0000u);
        ss[r][hd] = o0[r][hd] * o0[r][hd] + o1[r][hd] * o1[r][hd];
      }
#pragma unroll
    for (int r = 0; r < 2; ++r)
#pragma unroll
      for (int hd = 0; hd < 4; ++hd) ss[r][hd] = wave_sum(ss[r][hd]);
#pragma unroll
    for (int r = 0; r < 2; ++r)
#pragma unroll
      for (int hd = 0; hd < 4; ++hd) {
        const float rstd = rsqrtf(ss[r][hd] * (1.f / 128.f) + EPS);
        const float y0 = o0[r][hd] * rstd * hn.x * silu_f(__uint_as_float(ug[r][hd] << 16));
        const float y1 = o1[r][hd] * rstd * hn.y * silu_f(__uint_as_float(ug[r][hd] & 0xffff0000u));
        res[r][hd] = pk2(y0, y1);
      }
#pragma unroll
    for (int r = 0; r < 2; ++r)
#pragma unroll
      for (int hd = 0; hd < 4; ++hd) *(unsigned*)(p->r + (size_t)(2 * pi + r) * DM + 512 + hd * 128 + 2 * lane) = res[r][hd];
  }
}

DI void vt_job(PP p, int ja, int jb, unsigned char* smem) {
  bf16_t* T = (bf16_t*)smem;
  const int tid = threadIdx.x;
  const int row = tid >> 3, cseg = (tid & 7) * 32;
  bf16_t* dst; int dstL, pos0;
  if (jb < 64) {
    const int seq = jb >> 2; pos0 = (jb & 3) * 64;
    const bf16_t* src = p->z + (size_t)(seq * 256 + pos0 + row) * ZN_ATT + 1280 + cseg;
#pragma unroll
    for (int i = 0; i < 4; ++i) {
      bf16x8 v = *(const bf16x8*)(src + i * 8);
#pragma unroll
      for (int e = 0; e < 8; ++e) T[row * 258 + cseg + i * 8 + e] = (bf16_t)v[e];
    }
    dst = p->Vc + (size_t)seq * 2 * 128 * 256; dstL = 256;
  } else {
    const int jl = jb - 64, b = jl / 24, tile = jl % 24; pos0 = tile * 64;
    if (tile < 8) {
      const float* src = p->cache_v + ((size_t)(b * 2 + ja) * 512 + pos0 + row) * 256 + cseg;
#pragma unroll
      for (int i = 0; i < 8; ++i) {
        f32x4 v = *(const f32x4*)(src + i * 4);
#pragma unroll
        for (int e = 0; e < 4; ++e) T[row * 258 + cseg + i * 4 + e] = f2bf(v[e]);
      }
    } else {
      const bf16_t* src = p->z + (size_t)(NCTX + b * 1024 + pos0 - 512 + row) * ZN_ATT + 1280 + cseg;
#pragma unroll
      for (int i = 0; i < 4; ++i) {
        bf16x8 v = *(const bf16x8*)(src + i * 8);
#pragma unroll
        for (int e = 0; e < 8; ++e) T[row * 258 + cseg + i * 8 + e] = (bf16_t)v[e];
      }
    }
    dst = p->Vl + (size_t)b * 2 * 128 * 1536; dstL = 1536;
  }
  __syncthreads();
#pragma unroll
  for (int k = 0; k < 4; ++k) {
    int piece = tid + 512 * k, orow = piece >> 3, seg = piece & 7;
    uint4 o;
    o.x = (unsigned)T[(seg * 8 + 0) * 258 + orow] | ((unsigned)T[(seg * 8 + 1) * 258 + orow] << 16);
    o.y = (unsigned)T[(seg * 8 + 2) * 258 + orow] | ((unsigned)T[(seg * 8 + 3) * 258 + orow] << 16);
    o.z = (unsigned)T[(seg * 8 + 4) * 258 + orow] | ((unsigned)T[(seg * 8 + 5) * 258 + orow] << 16);
    o.w = (unsigned)T[(seg * 8 + 6) * 258 + orow] | ((unsigned)T[(seg * 8 + 7) * 258 + orow] << 16);
    *(uint4*)(dst + (size_t)orow * dstL + pos0 + seg * 8) = o;
  }
  __syncthreads();
}

DI void phase_kvprep(PP p, int ja, unsigned char* smem) {
  const int wave = threadIdx.x >> 6, lane = threadIdx.x & 63;
  float* outk = p->out + (size_t)NTOK * DM + 4194304;
  float* outv = outk + 2097152;
  const float2 wq = *(const float2*)(p->att_q_norm + ja * 128 + 2 * lane), wk = *(const float2*)(p->att_k_norm + ja * 128 + 2 * lane);
  const int stride = gridDim.x * 8;
  {
    int row = blockIdx.x * 8 + wave;
    unsigned u[10], un[10]; uint2 uv, uvn; float cs = 1.f, sn = 0.f, csn = 1.f, snn = 0.f;
#define KV_LOAD(R, U, UV, CS, SN) do { const bf16_t* zr_ = p->z + (size_t)(R) * ZN_ATT; \
      _Pragma("unroll") for (int hq = 0; hq < 10; ++hq) U[hq] = *(const unsigned*)(zr_ + hq * 128 + 2 * lane); \
      UV = *(const uint2*)(zr_ + 1280 + 4 * lane); \
      if ((R) >= NCTX) { const int t_ = ((R) - NCTX) & 1023; CS = p->ropec[t_ * 64 + lane]; SN = p->ropes[t_ * 64 + lane]; } else { CS = 1.f; SN = 0.f; } } while (0)
    if (row < NTOK) KV_LOAD(row, u, uv, cs, sn);
    while (row < NTOK) {
      const int nrow = row + stride;
      if (nrow < NTOK) KV_LOAD(nrow, un, uvn, csn, snn);
      const bool lat = row >= NCTX;
      const int b = lat ? ((row - NCTX) >> 10) : (row >> 8);
      const int t = lat ? ((row - NCTX) & 1023) : (row & 255);
      float r1[10], r2[10];
#pragma unroll
      for (int hq = 0; hq < 10; ++hq) {
        float x1 = __uint_as_float(u[hq] << 16), x2 = __uint_as_float(u[hq] & 0xffff0000u);
        float ss = wave_sum(x1 * x1 + x2 * x2);
        float rstd = rsqrtf(ss * (1.f / 128.f) + EPS);
        float y1 = x1 * rstd * ((hq < 8) ? wq.x : wk.x), y2 = x2 * rstd * ((hq < 8) ? wq.y : wk.y);
        r1[hq] = y1 * cs - y2 * sn; r2[hq] = y1 * sn + y2 * cs;
      }
#pragma unroll
      for (int hq = 0; hq < 8; ++hq) *(unsigned*)(p->h + (size_t)row * DM + hq * 128 + 2 * lane) = pk2(r1[hq], r2[hq]);
#pragma unroll
      for (int g = 0; g < 2; ++g) {
        if (!lat) {
          *(float2*)(outk + ((size_t)(b * 2 + ja) * 256 + t) * 256 + g * 128 + 2 * lane) = make_float2(r1[8 + g], r2[8 + g]);
          *(unsigned*)(p->Kc + ((size_t)b * 256 + t) * 256 + g * 128 + 2 * lane) = pk2(r1[8 + g], r2[8 + g]);
        } else {
          *(unsigned*)(p->Kl + ((size_t)b * 1536 + 512 + t) * 256 + g * 128 + 2 * lane) = pk2(r1[8 + g], r2[8 + g]);
        }
      }
      if (!lat) {
        f32x4 v = (f32x4){__uint_as_float(uv.x << 16), __uint_as_float(uv.x & 0xffff0000u), __uint_as_float(uv.y << 16), __uint_as_float(uv.y & 0xffff0000u)};
        *(f32x4*)(outv + ((size_t)(b * 2 + ja) * 256 + t) * 256 + 4 * lane) = v;
        *(uint2*)(p->Vc + ((size_t)b * 256 + t) * 256 + 4 * lane) = uv;
      } else {
        *(uint2*)(p->Vl + ((size_t)b * 1536 + 512 + t) * 256 + 4 * lane) = uv;
      }
#pragma unroll
      for (int hq = 0; hq < 10; ++hq) u[hq] = un[hq];
      uv = uvn; cs = csn; sn = snn; row = nrow;
    }
#undef KV_LOAD
  }
  for (int cr = blockIdx.x * 8 + wave; cr < 4096; cr += 2 * stride) {
    const int cr2 = cr + stride;
    const int b = cr >> 9, pp = cr & 511, b2 = (cr2 & 4095) >> 9, pp2 = cr2 & 511;
    const bool has2 = cr2 < 4096;
    f32x4 v = *(const f32x4*)(p->cache_k + ((size_t)(b * 2 + ja) * 512 + pp) * 256 + 4 * lane);
    f32x4 w = *(const f32x4*)(p->cache_v + ((size_t)(b * 2 + ja) * 512 + pp) * 256 + 4 * lane);
    f32x4 v2 = v, w2 = w;
    if (has2) { v2 = *(const f32x4*)(p->cache_k + ((size_t)(b2 * 2 + ja) * 512 + pp2) * 256 + 4 * lane);
                w2 = *(const f32x4*)(p->cache_v + ((size_t)(b2 * 2 + ja) * 512 + pp2) * 256 + 4 * lane); }
    uint2 o; o.x = pk2(v[0], v[1]); o.y = pk2(v[2], v[3]);
    *(uint2*)(p->Kl + ((size_t)b * 1536 + pp) * 256 + 4 * lane) = o;
    o.x = pk2(w[0], w[1]); o.y = pk2(w[2], w[3]);
    *(uint2*)(p->Vl + ((size_t)b * 1536 + pp) * 256 + 4 * lane) = o;
    if (has2) {
      o.x = pk2(v2[0], v2[1]); o.y = pk2(v2[2], v2[3]);
      *(uint2*)(p->Kl + ((size_t)b2 * 1536 + pp2) * 256 + 4 * lane) = o;
      o.x = pk2(w2[0], w2[1]); o.y = pk2(w2[2], w2[3]);
      *(uint2*)(p->Vl + ((size_t)b2 * 1536 + pp2) * 256 + 4 * lane) = o;
    }
  }
}

namespace att {
using bf16 = unsigned short;
constexpr int   D = 128, NW = 8, QBLK = 32, KVBLK = 64;
constexpr float SCALE = 0.088388347648318440f;
constexpr float THR = 8.f;
constexpr int SDEPTH = 2;
constexpr int LDQ = 1024, LDK = 256, LDO = 1024, LDG = 2560;
constexpr size_t SHM_V = KVBLK * D * 2, SHM_K = KVBLK * D * 2, SHM_ATTN = 2 * SHM_V + 2 * SHM_K + NW * 64 * 4;
using s16x4  = __attribute__((ext_vector_type(4))) short;
using f32x8  = __attribute__((ext_vector_type(8))) float;
using u32x4  = __attribute__((ext_vector_type(4))) unsigned;
#define KSWZ(row, colB) ((row) * 256 + ((colB) ^ (((row) & 7) << 4)))
#define SBAR() __builtin_amdgcn_sched_barrier(0)
__device__ __forceinline__ int crow(int r, int hi) { return (r & 3) + 8 * (r >> 2) + 4 * hi; }
__device__ __forceinline__ unsigned cvtpk(float lo, float hi) {
  unsigned r; asm volatile("v_cvt_pk_bf16_f32 %0, %1, %2" : "=v"(r) : "v"(lo), "v"(hi)); return r;
}
template <typename TIn> struct Stage;
template <> struct Stage<bf16>  { using T = bf16x8;
  __device__ static __forceinline__ T ld8(const bf16* p) { return *reinterpret_cast<const bf16x8*>(p); }
  __device__ static __forceinline__ bf16x8 tobf(T x) { return x; } };
__device__ __forceinline__ void partialSM(f32x16& p0, f32x16& p1, float& m_reg, float& mn, float& alpha) {
  constexpr float C = SCALE * 1.4426950408889634f;
  float pmax = p0[0]; for (int r = 1; r < 16; ++r) pmax = fmaxf(pmax, p0[r]); for (int r = 0; r < 16; ++r) pmax = fmaxf(pmax, p1[r]);
  { auto rr = __builtin_amdgcn_permlane32_swap(__float_as_uint(pmax), __float_as_uint(pmax), false, false);
    pmax = fmaxf(__uint_as_float(rr[0]), __uint_as_float(rr[1])); }
  if (__builtin_expect(__all(pmax - m_reg <= THR / SCALE), 1)) { mn = m_reg; alpha = 1.f; }
  else { mn = fmaxf(m_reg, pmax); alpha = __builtin_amdgcn_exp2f((m_reg - mn) * C); m_reg = mn; }
  float mnC = -mn * C;
  for (int r = 0; r < 16; ++r) p0[r] = fmaf(p0[r], C, mnC); for (int r = 0; r < 16; ++r) p1[r] = fmaf(p1[r], C, mnC);
  for (int r = 0; r < 16; ++r) p0[r] = __builtin_amdgcn_exp2f(p0[r]);
}
__device__ __forceinline__ void finishSM(f32x16& p0, f32x16& p1, float alpha, float& l_reg, bf16x8& pa0, bf16x8& pa1, bf16x8& pa2, bf16x8& pa3) {
  for (int r = 0; r < 16; ++r) p1[r] = __builtin_amdgcn_exp2f(p1[r]);
  float ps = 0; for (int r = 0; r < 16; ++r) ps += p0[r]; for (int r = 0; r < 16; ++r) ps += p1[r];
  { auto rr = __builtin_amdgcn_permlane32_swap(__float_as_uint(ps), __float_as_uint(ps), false, false);
    ps = __uint_as_float(rr[0]) + __uint_as_float(rr[1]); }
  l_reg = l_reg * alpha + ps;
#define PK4(P, BASE, OUT) do { unsigned a0 = cvtpk(P[BASE + 0], P[BASE + 1]), a1 = cvtpk(P[BASE + 2], P[BASE + 3]);   \
    unsigned b0 = cvtpk(P[BASE + 4], P[BASE + 5]), b1 = cvtpk(P[BASE + 6], P[BASE + 7]);                              \
    auto r0 = __builtin_amdgcn_permlane32_swap(a0, b0, false, false); auto r1 = __builtin_amdgcn_permlane32_swap(a1, b1, false, false); \
    u32x4 w = {r0[0], r1[0], r0[1], r1[1]}; OUT = *reinterpret_cast<bf16x8*>(&w); } while (0)
  PK4(p0, 0, pa0); PK4(p0, 8, pa1); PK4(p1, 0, pa2); PK4(p1, 8, pa3);
#undef PK4
}
__device__ __forceinline__ void qkt(f32x16& p0, f32x16& p1, const bf16* Ks, const bf16x8* qr, int r32, int hi) {
  p0 = f32x16{}; p1 = f32x16{};
  for (int d0 = 0; d0 < 8; ++d0) { int cb = (d0 * 16 + hi * 8) * 2;
    bf16x8 b0 = *reinterpret_cast<const bf16x8*>((const char*)Ks + KSWZ(r32, cb));
    bf16x8 b1 = *reinterpret_cast<const bf16x8*>((const char*)Ks + KSWZ(32 + r32, cb));
    p0 = __builtin_amdgcn_mfma_f32_32x32x16_bf16(b0, qr[d0], p0, 0, 0, 0);
    p1 = __builtin_amdgcn_mfma_f32_32x32x16_bf16(b1, qr[d0], p1, 0, 0, 0); }
}
__device__ __forceinline__ int v_st(int k, int c) { const int kk = (k & ~0xC) | ((k & 4) << 1) | ((k & 8) >> 1); return ((kk >> 3) * 4 + (c >> 5)) * 512 + ((kk & 7) * 32 + (c & 31)) * 2; }
__device__ __forceinline__ int v_rd_base(int lane) { return ((lane & 3) << 3) | (((lane >> 2) & 3) << 6) | (((lane >> 4) & 1) << 5) | (((lane >> 5) & 1) << 8); }
constexpr int v_rd_off(int d0, int ks, int half) { return d0 * 512 + ks * 4096 + half * 2048; }
template <int OFF> __device__ __forceinline__ s16x4 tr_read(int vb) {
  s16x4 r; asm volatile("ds_read_b64_tr_b16 %0, %1 offset:%2" : "=&v"(r) : "v"(vb), "i"(OFF) : "memory"); return r;
}
template <int D0> __device__ __forceinline__ void pv_one(f32x16& od, int vb, bf16x8 pa0, bf16x8 pa1, bf16x8 pa2, bf16x8 pa3) {
  const s16x4 l0 = tr_read<v_rd_off(D0, 0, 0)>(vb), h0 = tr_read<v_rd_off(D0, 0, 1)>(vb), l1 = tr_read<v_rd_off(D0, 1, 0)>(vb), h1 = tr_read<v_rd_off(D0, 1, 1)>(vb);
  const s16x4 l2 = tr_read<v_rd_off(D0, 2, 0)>(vb), h2 = tr_read<v_rd_off(D0, 2, 1)>(vb), l3 = tr_read<v_rd_off(D0, 3, 0)>(vb), h3 = tr_read<v_rd_off(D0, 3, 1)>(vb);
  asm volatile("s_waitcnt lgkmcnt(0)" ::: "memory"); SBAR();
#define PK(L, H) (bf16x8){L[0], L[1], L[2], L[3], H[0], H[1], H[2], H[3]}
  od = __builtin_amdgcn_mfma_f32_32x32x16_bf16(pa0, PK(l0, h0), od, 0, 0, 0);
  od = __builtin_amdgcn_mfma_f32_32x32x16_bf16(pa1, PK(l1, h1), od, 0, 0, 0);
  od = __builtin_amdgcn_mfma_f32_32x32x16_bf16(pa2, PK(l2, h2), od, 0, 0, 0);
  od = __builtin_amdgcn_mfma_f32_32x32x16_bf16(pa3, PK(l3, h3), od, 0, 0, 0);
#undef PK
}
__device__ __forceinline__ void pv_d0(f32x16* o, int vb, bf16x8 pa0, bf16x8 pa1, bf16x8 pa2, bf16x8 pa3) {
  pv_one<0>(o[0], vb, pa0, pa1, pa2, pa3); pv_one<1>(o[1], vb, pa0, pa1, pa2, pa3); pv_one<2>(o[2], vb, pa0, pa1, pa2, pa3); pv_one<3>(o[3], vb, pa0, pa1, pa2, pa3);
}

template <typename TQ>
__device__ __forceinline__ void attn_dense_body(const TQ* __restrict__ Qb, const bf16* __restrict__ Kh, const bf16* __restrict__ Vh,
                                                const bf16* __restrict__ Gb, bf16* __restrict__ Ob, int seq, char* lds) {
  using St = Stage<bf16>; using SQ = Stage<TQ>;
  const int tid = threadIdx.x, wid = tid >> 6, lane = tid & 63, r32 = lane & 31, hi = lane >> 5;
  bf16* V_lds = (bf16*)lds; bf16* K_lds = (bf16*)(lds + 2 * SHM_V);
  float* ws = (float*)(lds + 2 * SHM_V + 2 * SHM_K) + wid * 64; float* li_l = ws; float* al_l = ws + 32;
  float m_reg = -1e30f, l_reg = 0; f32x16 o[4] = {}; bf16x8 qr[8];
  const TQ* Qw = Qb + (long)(wid * QBLK + r32) * LDQ + hi * 8;
#pragma unroll
  for (int d0 = 0; d0 < 8; ++d0) qr[d0] = SQ::tobf(SQ::ld8(Qw + d0 * 16));
  const int sr = tid >> 4, sc = (tid & 15) * 8, vst0 = v_st(sr, sc), vst1 = v_st(32 + sr, sc);
  const int vb0 = (int)(uintptr_t)V_lds + v_rd_base(lane);
  struct { typename St::T vs0, vs1, ks0, ks1; } sr_[SDEPTH];
#define SLOAD(i, k0) do { sr_[i].vs0 = St::ld8(&Vh[(long)((k0) + sr) * LDK + sc]); sr_[i].vs1 = St::ld8(&Vh[(long)((k0) + 32 + sr) * LDK + sc]); \
    sr_[i].ks0 = St::ld8(&Kh[(long)((k0) + sr) * LDK + sc]); sr_[i].ks1 = St::ld8(&Kh[(long)((k0) + 32 + sr) * LDK + sc]); } while (0)
#define SWRITE(b, i) do { *(bf16x8*)((char*)V_lds + (b) * SHM_V + vst0) = St::tobf(sr_[i].vs0);          \
    *(bf16x8*)((char*)V_lds + (b) * SHM_V + vst1) = St::tobf(sr_[i].vs1); int kc = sc * 2;               \
    *(bf16x8*)((char*)K_lds + (b) * SHM_K + KSWZ(sr, kc)) = St::tobf(sr_[i].ks0);                       \
    *(bf16x8*)((char*)K_lds + (b) * SHM_K + KSWZ(32 + sr, kc)) = St::tobf(sr_[i].ks1); } while (0)
#define SWAIT() do { if constexpr (SDEPTH == 2) asm volatile("s_waitcnt vmcnt(4)" ::: "memory"); else asm volatile("s_waitcnt vmcnt(0)" ::: "memory"); } while (0)
#define RESC(a) do { if (__any((a) < 1.f)) { if (hi == 0) al_l[r32] = (a); asm volatile("s_waitcnt lgkmcnt(0)" ::: "memory"); \
    for (int d = 0; d < 4; ++d) for (int r = 0; r < 16; ++r) o[d][r] *= al_l[crow(r, hi)]; } } while (0)
  f32x16 pA0, pA1, pB0, pB1; float mnA, mnB, alA, alB; bf16x8 pa0, pa1, pa2, pa3; const int NT = seq / KVBLK;
  constexpr int SE = 0, SO = SDEPTH - 1;
  SLOAD(SE, 0); asm volatile("s_waitcnt vmcnt(0)" ::: "memory"); SWRITE(0, SE); __syncthreads();
  qkt(pA0, pA1, K_lds, qr, r32, hi); partialSM(pA0, pA1, m_reg, mnA, alA);
  SLOAD(SO, KVBLK); if constexpr (SDEPTH == 2) { if (2 < NT) SLOAD(SE, 2 * KVBLK); }
  SWAIT(); SWRITE(1, SO); __syncthreads();
  for (int j = 1; j + 1 < NT; j += 2) {
    SBAR(); qkt(pB0, pB1, (bf16*)((char*)K_lds + SHM_K), qr, r32, hi);
    finishSM(pA0, pA1, alA, l_reg, pa0, pa1, pa2, pa3); SBAR();
    SLOAD(SO, (j + SDEPTH) * KVBLK); SBAR();
    pv_d0(o, vb0, pa0, pa1, pa2, pa3); partialSM(pB0, pB1, m_reg, mnB, alB);
    __syncthreads(); SWAIT(); SWRITE(0, SE);
    RESC(alB); __syncthreads();
    SBAR(); qkt(pA0, pA1, K_lds, qr, r32, hi);
    finishSM(pB0, pB1, alB, l_reg, pa0, pa1, pa2, pa3); SBAR();
    if (SDEPTH == 1 || j + 3 < NT) SLOAD(SE, (j + 1 + SDEPTH) * KVBLK); SBAR();
    pv_d0(o, vb0 + (int)SHM_V, pa0, pa1, pa2, pa3); partialSM(pA0, pA1, m_reg, mnA, alA);
    __syncthreads(); SWAIT(); SWRITE(1, SO);
    RESC(alA); __syncthreads();
  }
  SBAR(); qkt(pB0, pB1, (bf16*)((char*)K_lds + SHM_K), qr, r32, hi);
  finishSM(pA0, pA1, alA, l_reg, pa0, pa1, pa2, pa3); SBAR();
  pv_d0(o, vb0, pa0, pa1, pa2, pa3); partialSM(pB0, pB1, m_reg, mnB, alB);
  __syncthreads(); RESC(alB);
  finishSM(pB0, pB1, alB, l_reg, pa0, pa1, pa2, pa3); SBAR();
  pv_d0(o, vb0 + (int)SHM_V, pa0, pa1, pa2, pa3);
  if (hi == 0) li_l[r32] = l_reg; asm volatile("s_waitcnt lgkmcnt(0)" ::: "memory");
  float rli[16];
#pragma unroll
  for (int r = 0; r < 16; ++r) rli[r] = __builtin_amdgcn_rcpf(li_l[crow(r, hi)]);
  int lofs = 4 * hi; asm volatile("" : "+v"(lofs));
  const bf16* Gw = Gb + (long)(wid * QBLK + lofs) * LDG + r32; bf16* Ow = Ob + (long)(wid * QBLK + lofs) * LDO + r32;
#pragma unroll
  for (int d0 = 0; d0 < 4; ++d0) {
    unsigned short gv[16];
#pragma unroll
    for (int r = 0; r < 16; ++r) gv[r] = Gw[(long)((r & 3) + 8 * (r >> 2)) * LDG + d0 * 32];
#pragma unroll
    for (int r = 0; r < 16; ++r) {
      const float g = __uint_as_float(((unsigned)gv[r]) << 16);
      const float val = o[d0][r] * rli[r] * (g * __builtin_amdgcn_rcpf(1.f + __expf(-g)));
      Ow[(long)((r & 3) + 8 * (r >> 2)) * LDO + d0 * 32] = (bf16)(cvtpk(val, 0.f) & 0xffffu);
    }
  }
#undef SLOAD
#undef SWRITE
#undef SWAIT
#undef RESC
}

#undef KSWZ
#undef SBAR
}

DI void att_item(PP p, int qrow0, int head, const bf16_t* Kb, const bf16_t* Vb, int Lk, unsigned char* smem) {
  __syncthreads();
  att::attn_dense_body<att::bf16>(p->h + (size_t)qrow0 * DM + head * 128, Kb, Vb, p->z + (size_t)qrow0 * ZN_ATT + 1536 + head * 128,
                                  p->r + (size_t)qrow0 * DM + head * 128, Lk, (char*)smem);
}

DI void phase_att(PP p, unsigned char* smem) {
  for (int item = blockIdx.x; item < 384; item += gridDim.x) {
    int qrow0, head, Lk; const bf16_t* Kb; const bf16_t* Vb;
    if (item < 256) {
      const int xcd = item & 7, slot = item >> 3;
      const int bg = xcd * 2 + (slot >> 4), within = slot & 15;
      const int b = bg >> 1, g = bg & 1, qt = within & 3;
      head = g * 4 + (within >> 2); qrow0 = NCTX + b * 1024 + qt * 256; Lk = 1536;
      Kb = p->Kl + (size_t)b * 1536 * 256 + g * 128; Vb = p->Vl + (size_t)b * 1536 * 256 + g * 128;
    } else {
      const int id2 = item - 256, xcd = id2 & 7, slot = id2 >> 3;
      const int grp = xcd * 4 + (slot >> 2), seq = grp >> 1, g = grp & 1;
      head = g * 4 + (slot & 3); qrow0 = seq * 256; Lk = 256;
      Kb = p->Kc + (size_t)seq * 256 * 256 + g * 128; Vb = p->Vc + (size_t)seq * 256 * 256 + g * 128;
    }
    att_item(p, qrow0, head, Kb, Vb, Lk, smem);
  }
}

#define XB_TMO      128
#define XB_XCNT(j)  (256  + 64 * (j))
#define XB_XSUB(j)  (1280 + 64 * (j))
#define XB_XGEN(j)  (2304 + 64 * (j))
#define XB_TOP      3328
#define XB_TOPGEN   3392
#define XCD_BAR_WORDS 3456
#define XB_SPIN_CAP (1u << 18)
DI unsigned xb_ld(unsigned* p) { return __hip_atomic_load(p, __ATOMIC_RELAXED, __HIP_MEMORY_SCOPE_AGENT); }
DI unsigned xb_add(unsigned* p, unsigned v) { return __hip_atomic_fetch_add(p, v, __ATOMIC_RELAXED, __HIP_MEMORY_SCOPE_AGENT); }
DI unsigned xb_xcc_id() { return (unsigned)__builtin_amdgcn_s_getreg((3 << 11) | 20) & 0xFu; }
#define XB_SPIN(cond, bar) do { unsigned _sp = 0; while (cond) { __builtin_amdgcn_s_sleep(1); \
    if ((++_sp & 255u) == 0u) { if (xb_ld(&(bar)[XB_TMO])) break; if (_sp > XB_SPIN_CAP) { atomicAdd(&(bar)[XB_TMO], 1u); break; } } } } while (0)
DI void xcd_barrier_complete(unsigned* bar, unsigned x, unsigned& nloc, unsigned& nx) {
  const unsigned G = gridDim.x;
  unsigned sum, cnt, mine, sp = 0u;
  for (;;) {
    sum = 0u; cnt = 0u; mine = 0u;
#pragma unroll
    for (unsigned j = 0; j < 16; ++j) { const unsigned c = xb_ld(&bar[XB_XCNT(j)]); sum += c; cnt += (c > 0u) ? 1u : 0u; mine = (j == x) ? c : mine; }
    if (sum == G) break;
    __builtin_amdgcn_s_sleep(1);
    if ((++sp & 255u) == 0u) { if (xb_ld(&bar[XB_TMO])) break; if (sp > XB_SPIN_CAP) { atomicAdd(&bar[XB_TMO], 1u); break; } }
  }
  nloc = mine > 0u ? mine : 1u; nx = cnt > 0u ? cnt : 1u;
}
DI void xcd_barrier(unsigned* bar, volatile LAS unsigned* st) {
  asm volatile("s_waitcnt vmcnt(0)" ::: "memory");
  __syncthreads();
  if (threadIdx.x == 0) {
    const unsigned x = xb_xcc_id();
    __builtin_amdgcn_s_waitcnt(0);
    unsigned nloc = st[0], nx = st[1];
    if (nloc == 0u) { xcd_barrier_complete(bar, x, nloc, nx); st[0] = nloc; st[1] = nx; }
    const unsigned old = xb_add(&bar[XB_XSUB(x)], 1u);
    const unsigned gen = old / nloc;
    if (old + 1u == (gen + 1u) * nloc) {
      __builtin_amdgcn_fence(__ATOMIC_RELEASE, "agent");
      asm volatile("s_waitcnt vmcnt(0)" ::: "memory");
      const unsigned og = xb_add(&bar[XB_TOP], 1u);
      const unsigned tg = og / nx;
      __builtin_amdgcn_fence(__ATOMIC_ACQUIRE, "agent");
      if (og + 1u == (tg + 1u) * nx) xb_add(&bar[XB_TOPGEN], 1u);
      else XB_SPIN(xb_ld(&bar[XB_TOPGEN]) == tg, bar);
      xb_add(&bar[XB_XGEN(x)], 1u);
      asm volatile("s_waitcnt vmcnt(0)" ::: "memory");
    } else {
      __builtin_amdgcn_fence(__ATOMIC_ACQUIRE, "agent");
      XB_SPIN(xb_ld(&bar[XB_XGEN(x)]) == gen, bar);
      asm volatile("s_waitcnt vmcnt(0)" ::: "memory");
    }
  }
  __syncthreads();
}

__global__ void __launch_bounds__(NTHR, 2) mega(Params p_arg) {
  extern __shared__ __attribute__((aligned(16))) unsigned char smem[];
  __shared__ uint4 xb_words;
  PP p0 = (PP)__builtin_amdgcn_kernarg_segment_ptr();
  const int ph_lo = p0->ph_lo, ph_hi = p0->ph_hi, coop = p0->coop;
  if (threadIdx.x == 0) xb_words = make_uint4(0u, 0u, 0u, 0u);
  __syncthreads();
  if (coop && threadIdx.x == 0) (void)xb_add(&p0->bar[XB_XCNT(xb_xcc_id())], 1u);
  if (p0->pad == 0x7fffffff) cg::this_grid().sync();
#define PH(k, rep, ...) { if (ph_lo <= (k) && (k) < ph_hi) { for (int rep_ = 0; rep_ < (rep); ++rep_) { PP p = (PP)__builtin_amdgcn_kernarg_segment_ptr(); asm volatile("" : "+s"(p)); __VA_ARGS__; } \
    if ((k) + 1 < ph_hi && coop) xcd_barrier(p0->bar, (volatile LAS unsigned*)&xb_words); } }
  PH(0, REP_PREP, prep_jobs(p, smem, 0, blockIdx.x, gridDim.x))
  if (coop) for (int e = 0; e < EXTRA_SYNC; ++e) xcd_barrier(p0->bar, (volatile LAS unsigned*)&xb_words);
  PH(1, 1, phase_row(p, -1))
  PH(2, REP_GEMM, phase_rec_in(p, 0, smem))
  PH(3, REP_SCAN, phase_scan(p, 0, smem))
  PH(4, REP_CHAIN, phase_chain(p, 0, smem))
  PH(5, REP_COMB, phase_combine(p, 0))
  PH(6, REP_GEMM, EpiBf16 E{(bf16_t*)p->oproj, 1024}; phase_gemm(p->r, p->WrecoT, 1024, E, smem); if (gridDim.x > 192) { if (blockIdx.x >= 192) prep_jobs(p, smem, 1, blockIdx.x - 192, gridDim.x - 192); } else prep_jobs(p, smem, 1, blockIdx.x, gridDim.x))
  PH(7, 1, phase_row(p, 0))
  PH(8, REP_GEMM, EpiBf16 E{p->z, ZN_ATT}; phase_gemm(p->h, p->WattT, ZN_ATT, E, smem))
  PH(9, 1, phase_kvprep(p, 0, smem))
  PH(10, REP_ATT, phase_att(p, smem))
  PH(11, REP_GEMM, EpiBf16 E{(bf16_t*)p->oproj, 1024}; phase_gemm(p->r, p->WattoT, 1024, E, smem); if (gridDim.x > 192) { if (blockIdx.x >= 192) prep_jobs(p, smem, 2, blockIdx.x - 192, gridDim.x - 192); } else prep_jobs(p, smem, 2, blockIdx.x, gridDim.x))
  PH(12, 1, phase_row(p, 1))
  PH(13, REP_GEMM, phase_rec_in(p, 1, smem))
  PH(14, REP_SCAN, phase_scan(p, 1, smem))
  PH(15, REP_CHAIN, phase_chain(p, 1, smem))
  PH(16, REP_COMB, phase_combine(p, 1))
  PH(17, REP_GEMM, EpiBf16 E{(bf16_t*)p->oproj, 1024}; phase_gemm(p->r, p->WrecoT + (size_t)1024 * 1024, 1024, E, smem); if (gridDim.x > 192) { if (blockIdx.x >= 192) prep_jobs(p, smem, 3, blockIdx.x - 192, gridDim.x - 192); } else prep_jobs(p, smem, 3, blockIdx.x, gridDim.x))
  PH(18, 1, phase_row(p, 2))
  PH(19, REP_GEMM, EpiBf16 E{p->z, ZN_ATT}; phase_gemm(p->h, p->WattT + (size_t)ZN_ATT * 1024, ZN_ATT, E, smem))
  PH(20, 1, phase_kvprep(p, 1, smem))
  PH(21, REP_ATT, phase_att(p, smem))
  PH(22, REP_GEMM, EpiBf16 E{(bf16_t*)p->oproj, 1024}; phase_gemm(p->r, p->WattoT + (size_t)1024 * 1024, 1024, E, smem))
  PH(23, 1, phase_row(p, 3))
}

extern "C" void kernel_launch(void* const* d_in, const int* in_sizes, int n_in, void* d_out, int out_size, void* d_ws, size_t ws_size, hipStream_t stream) {
  static int grid = 0;
  if (grid == 0) {
    int dev = 0, cus = 0, per_cu = 0;
    hipGetDevice(&dev);
    hipDeviceGetAttribute(&cus, hipDeviceAttributeMultiprocessorCount, dev);
    hipFuncSetAttribute((const void*)mega, hipFuncAttributeMaxDynamicSharedMemorySize, LDS_BYTES);
    hipOccupancyMaxActiveBlocksPerMultiprocessor(&per_cu, (const void*)mega, NTHR, LDS_BYTES);
    if (per_cu < 1) per_cu = 1;
    grid = cus * 1;
    if (grid <= 0) grid = 256;
  }
  Params hp{};
  const float* const* in = (const float* const*)d_in;
  hp.x_prompt = in[0]; hp.x_sample = in[1]; hp.c = in[2]; hp.state = in[3]; hp.cache_k = in[4]; hp.cache_v = in[5]; hp.c_ctx = in[6];
  hp.ada_w = in[7]; hp.ada_b = in[8]; hp.norm_pre = in[9]; hp.norm_post = in[10]; hp.rec_w_in = in[11]; hp.rec_lb = in[12];
  hp.rec_head_norm = in[13]; hp.pool_w = in[14]; hp.pool_scale = in[15]; hp.rec_w_out = in[16]; hp.att_w_in = in[17];
  hp.att_q_norm = in[18]; hp.att_k_norm = in[19]; hp.att_w_out = in[20];
  hp.out = (float*)d_out;
  unsigned char* w = (unsigned char*)d_ws;
  size_t off = 0;
  auto take = [&](size_t bytes) { unsigned char* q = w + off; off += (bytes + 255) & ~(size_t)255; return q; };
  hp.WrecT = (bf16_t*)take((size_t)2 * ZN_REC * 1024 * 2);
  hp.WrecoT = (bf16_t*)take((size_t)2 * 1024 * 1024 * 2);
  hp.WattT = (bf16_t*)take((size_t)2 * ZN_ATT * 1024 * 2);
  hp.WattoT = (bf16_t*)take((size_t)2 * 1024 * 1024 * 2);
  hp.mod = (float*)take((size_t)4 * 9 * 3072 * 4);
  hp.lb = (float*)take(2048 * 4);
  hp.ropec = (float*)take(1024 * 64 * 4);
  hp.ropes = (float*)take(1024 * 64 * 4);
  hp.z = (bf16_t*)take((size_t)NTOK * ZN_REC * 2);
  hp.r = (bf16_t*)take((size_t)NTOK * DM * 2);
  hp.oproj = (float*)take((size_t)NTOK * DM * 4);
  hp.bar = (unsigned*)take(XCD_BAR_WORDS * 4);
  hp.h = (bf16_t*)take((size_t)NTOK * DM * 2);
  hp.Kc = (bf16_t*)take((size_t)16 * 256 * 256 * 2);
  hp.Kl = (bf16_t*)take((size_t)8 * 1536 * 256 * 2);
  hp.Vc = (bf16_t*)take((size_t)16 * 256 * 256 * 2);
  hp.Vl = (bf16_t*)take((size_t)8 * 1536 * 256 * 2);
  {
    const size_t k_off = (size_t)((unsigned char*)hp.Kc - w);
    const size_t need = k_off + (size_t)(1536 - 2 * 438) * 57344;
    if (off < need) off = need;
  }
  if (off > ws_size) { fprintf(stderr, "workspace too small: need %zu have %zu\n", off, ws_size); return; }
  (void)hipMemsetAsync(hp.bar, 0, XCD_BAR_WORDS * 4, stream);
#if MULTI_LAUNCH
  for (int ph = 0; ph < NPHASE; ++ph) {
    hp.ph_lo = ph; hp.ph_hi = ph + 1; hp.coop = 0;
    hipLaunchKernelGGL(mega, dim3(grid), dim3(NTHR), LDS_BYTES, stream, hp);
  }
#else
  hp.ph_lo = 0; hp.ph_hi = NPHASE; hp.coop = 1;
  void* args[] = {&hp};
  hipError_t e = hipLaunchCooperativeKernel((const void*)mega, dim3(grid), dim3(NTHR), args, LDS_BYTES, stream);
  if (e != hipSuccess) fprintf(stderr, "cooperative launch failed: %s (grid %d)\n", hipGetErrorString(e), grid);
#endif
}
```

```cpp
#include <hip/hip_runtime.h>
#include <hip/hip_cooperative_groups.h>
#include <cstdio>
#include <cstdint>
namespace cg = cooperative_groups;

#ifndef MULTI_LAUNCH
#define MULTI_LAUNCH 0
#endif
#define REP_PREP 1
#define REP_GEMM 1
#define REP_SCAN 1
#define REP_CHAIN 1
#define REP_COMB 1
#define REP_ATT 1
#define EXTRA_SYNC 0

typedef unsigned short bf16_t;
typedef short bf16x8 __attribute__((ext_vector_type(8)));
typedef short bf16x4 __attribute__((ext_vector_type(4)));
typedef float f32x4 __attribute__((ext_vector_type(4)));
typedef float f32x16 __attribute__((ext_vector_type(16)));

#define DI __device__ __forceinline__

constexpr int DM = 1024;
constexpr int NTOK = 12288;
constexpr int NCTX = 4096;
constexpr int ZN_REC = 3584;
constexpr int ZN_ATT = 2560;
constexpr int NTHR = 512;
constexpr int LDS_BYTES = 131072;
constexpr float EPS = 1e-6f;
constexpr int NPHASE = 24;

struct Params;
typedef const __attribute__((address_space(4))) Params* PP;
struct Params {
  const float *x_prompt, *x_sample, *c, *state, *cache_k, *cache_v, *c_ctx, *ada_w, *ada_b, *norm_pre, *norm_post;
  const float *rec_w_in, *rec_lb, *rec_head_norm, *pool_w, *pool_scale, *rec_w_out, *att_w_in, *att_q_norm, *att_k_norm, *att_w_out;
  float* out;
  bf16_t *WrecT, *WrecoT, *WattT, *WattoT;
  float *mod, *lb, *ropec, *ropes;
  bf16_t *h, *z, *r;
  float* oproj;
  bf16_t *Kc, *Kl, *Vc, *Vl;
  unsigned* bar;
  int ph_lo, ph_hi, coop, pad;
};

DI bf16_t f2bf(float f) { unsigned u = __float_as_uint(f); u += 0x7fffu + ((u >> 16) & 1u); return (bf16_t)(u >> 16); }
DI float bf2f(bf16_t b) { return __uint_as_float(((unsigned)b) << 16); }
DI float bfs(short b) { return __uint_as_float(((unsigned)(unsigned short)b) << 16); }
typedef __bf16 bf16v2_t __attribute__((ext_vector_type(2)));
typedef float f32v2_t __attribute__((ext_vector_type(2)));
DI unsigned pk2(float a, float b) { f32v2_t v = {a, b}; return __builtin_bit_cast(unsigned, __builtin_convertvector(v, bf16v2_t)); }
DI float wave_sum(float v) {
  { auto r = __builtin_amdgcn_permlane32_swap(__float_as_uint(v), __float_as_uint(v), false, false); v = __uint_as_float(r[0]) + __uint_as_float(r[1]); }
  { auto r = __builtin_amdgcn_permlane16_swap(__float_as_uint(v), __float_as_uint(v), false, false); v = __uint_as_float(r[0]) + __uint_as_float(r[1]); }
  v += __uint_as_float(__builtin_amdgcn_update_dpp(0, __float_as_uint(v), 0x128, 0xf, 0xf, false));
  v += __uint_as_float(__builtin_amdgcn_update_dpp(0, __float_as_uint(v), 0x124, 0xf, 0xf, false));
  v += __uint_as_float(__builtin_amdgcn_update_dpp(0, __float_as_uint(v), 0x122, 0xf, 0xf, false));
  v += __uint_as_float(__builtin_amdgcn_update_dpp(0, __float_as_uint(v), 0x121, 0xf, 0xf, false));
  return v;
}
typedef unsigned u32x4_t __attribute__((ext_vector_type(4)));
DI void st16_wt(void* ptr, uint4 v) { u32x4_t w = {v.x, v.y, v.z, v.w}; asm volatile("global_store_dwordx4 %0, %1, off sc1\n\ts_nop 1" :: "v"(ptr), "v"(w) : "memory"); }
DI void lds_barrier() { asm volatile("s_waitcnt lgkmcnt(0)\n\ts_barrier" ::: "memory"); }
DI float silu_f(float x) { return x * __builtin_amdgcn_rcpf(1.f + __expf(-x)); }
DI f32x16 mfma32(bf16x8 a, bf16x8 b, f32x16 c) { return __builtin_amdgcn_mfma_f32_32x32x16_bf16(a, b, c, 0, 0, 0); }
DI bf16x8 pack8(const f32x16& x, int s) {
  uint4 w;
  w.x = pk2(x[8 * s + 0], x[8 * s + 1]); w.y = pk2(x[8 * s + 2], x[8 * s + 3]);
  w.z = pk2(x[8 * s + 4], x[8 * s + 5]); w.w = pk2(x[8 * s + 6], x[8 * s + 7]);
  return __builtin_bit_cast(bf16x8, w);
}

DI void tr_tile(const float* src, int ld, int k0, int n0, bf16_t* dst, int nd0, float* T) {
  const int tid = threadIdx.x;
#pragma unroll
  for (int i = 0; i < 2; ++i) {
    int idx = tid + 512 * i, kk = idx >> 4, c4 = idx & 15;
    f32x4 v = *(const f32x4*)(src + (size_t)(k0 + kk) * ld + n0 + c4 * 4);
    T[kk * 65 + c4 * 4 + 0] = v[0]; T[kk * 65 + c4 * 4 + 1] = v[1]; T[kk * 65 + c4 * 4 + 2] = v[2]; T[kk * 65 + c4 * 4 + 3] = v[3];
  }
  __syncthreads();
  {
    int nn = tid >> 3, k8 = (tid & 7) * 8;
    uint4 o;
    o.x = pk2(T[(k8 + 0) * 65 + nn], T[(k8 + 1) * 65 + nn]);
    o.y = pk2(T[(k8 + 2) * 65 + nn], T[(k8 + 3) * 65 + nn]);
    o.z = pk2(T[(k8 + 4) * 65 + nn], T[(k8 + 5) * 65 + nn]);
    o.w = pk2(T[(k8 + 6) * 65 + nn], T[(k8 + 7) * 65 + nn]);
    *(uint4*)(dst + (size_t)(nd0 + nn) * 1024 + k0 + k8) = o;
  }
  __syncthreads();
}

constexpr int J_MOD = 192, J_FOLD = 128, J_MISC = 8;
constexpr int J_TR_REC = 16 * 48, J_TR_RECO = 256, J_TR_ATT = 16 * 40, J_TR_ATTO = 256;
constexpr int J_TR_PER = J_TR_REC + J_TR_RECO + J_TR_ATT + J_TR_ATTO;
constexpr int J_TOTAL = J_MOD + J_FOLD + J_MISC + 2 * J_TR_PER;

constexpr int J_FIRST = J_MOD + J_FOLD + J_MISC;
DI int map_job(int group, int v) {
  if (group == 0) {
    if (v < 192) return v;
    v -= 192; if (v < 8) return 320 + v;
    v -= 8; if (v < 128) return 192 + v;
    v -= 128; if (v < 1024) return J_FIRST + v;
    return -1;
  } else if (group == 1) {
    return (v < 896) ? J_FIRST + 1024 + v : -1;
  } else if (group == 2) {
    return (v < 1024) ? J_FIRST + J_TR_PER + v : -1;
  } else {
    return (v < 896) ? J_FIRST + J_TR_PER + 1024 + v : -1;
  }
}
DI void prep_jobs(PP p, unsigned char* smem, int group, int vb, int nb) {
  const int tid = threadIdx.x, wave = tid >> 6, lane = tid & 63;
  int v = vb;
  for (;; v += nb) {
    const int job = map_job(group, v);
    if (job < 0 || job >= J_FIRST) break;
    int jb = job;
    if (jb < J_MOD) {
      const int i = jb / 48, col0 = (jb % 48) * 64;
      float* sv = (float*)smem;
      float* red = sv + 9 * 1024;
      for (int e = tid; e < 9 * 1024; e += NTHR) {
        int r = e >> 10, k = e & 1023;
        float cv = (r == 0) ? p->c_ctx[k] : p->c[(r - 1) * 1024 + k];
        sv[e] = silu_f(cv);
      }
      __syncthreads();
      float acc[9];
#pragma unroll
      for (int r = 0; r < 9; ++r) acc[r] = 0.f;
      const float* wp = p->ada_w + ((size_t)i * 1024 + wave * 128) * 3072 + col0 + lane;
#pragma unroll 16
      for (int k = 0; k < 128; ++k) {
        float wv = wp[(size_t)k * 3072];
#pragma unroll
        for (int r = 0; r < 9; ++r) acc[r] += sv[r * 1024 + wave * 128 + k] * wv;
      }
#pragma unroll
      for (int r = 0; r < 9; ++r) red[(wave * 9 + r) * 64 + lane] = acc[r];
      __syncthreads();
      for (int e = tid; e < 9 * 64; e += NTHR) {
        int r = e >> 6, l = e & 63;
        float s = 0.f;
#pragma unroll
        for (int w = 0; w < 8; ++w) s += red[(w * 9 + r) * 64 + l];
        p->mod[((size_t)i * 9 + r) * 3072 + col0 + l] = s + p->ada_b[i * 3072 + col0 + l];
      }
      __syncthreads();
      continue;
    }
    jb -= J_MOD;
    if (jb < J_FOLD) {
      const int j = jb >> 6, g = (jb >> 4) & 3, kt = jb & 15, k0 = kt * 64;
      float* Wt = (float*)smem;
      for (int e = tid; e < 64 * 32; e += NTHR) {
        int kk = e >> 5, c4 = e & 31;
        f32x4 v = *(const f32x4*)(p->rec_w_in + ((size_t)j * 1024 + k0 + kk) * ZN_REC + g * 128 + c4 * 4);
        Wt[kk * 129 + c4 * 4 + 0] = v[0]; Wt[kk * 129 + c4 * 4 + 1] = v[1]; Wt[kk * 129 + c4 * 4 + 2] = v[2]; Wt[kk * 129 + c4 * 4 + 3] = v[3];
      }
      __syncthreads();
      const int cp = tid & 127, kq = tid >> 7;
      float acc[16];
#pragma unroll
      for (int i = 0; i < 16; ++i) acc[i] = 0.f;
      const float* pw = p->pool_w + ((size_t)(j * 4 + g) * 128) * 128 + cp;
      for (int c = 0; c < 128; ++c) {
        float w = pw[(size_t)c * 128];
#pragma unroll
        for (int i = 0; i < 16; ++i) acc[i] += Wt[(kq * 16 + i) * 129 + c] * w;
      }
      float sc = p->pool_scale[j * 512 + g * 128 + cp];
      uint4 o0, o1;
      o0.x = pk2(acc[0] * sc, acc[1] * sc); o0.y = pk2(acc[2] * sc, acc[3] * sc); o0.z = pk2(acc[4] * sc, acc[5] * sc); o0.w = pk2(acc[6] * sc, acc[7] * sc);
      o1.x = pk2(acc[8] * sc, acc[9] * sc); o1.y = pk2(acc[10] * sc, acc[11] * sc); o1.z = pk2(acc[12] * sc, acc[13] * sc); o1.w = pk2(acc[14] * sc, acc[15] * sc);
      bf16_t* dp = p->WrecT + ((size_t)j * ZN_REC + g * 128 + cp) * 1024 + k0 + kq * 16;
      *(uint4*)dp = o0; *(uint4*)(dp + 8) = o1;
      __syncthreads();
      continue;
    }
    jb -= J_FOLD;
    if (jb < J_MISC) {
      for (int e = tid; e < 128 * 64; e += NTHR) {
        int t = jb * 128 + (e >> 6), i = e & 63;
        int fi = i & 31;
        float inv = exp2f(-(float)(2 * fi) * (13.287712379549449f / 64.f));
        float pos = (i < 32) ? (float)(t >> 6) : (float)(t & 63);
        float ang = pos * inv;
        p->ropec[t * 64 + i] = __cosf(ang);
        p->ropes[t * 64 + i] = __sinf(ang);
      }
      if (jb == 0) {
        for (int e = tid; e < 1024; e += NTHR) {
          float a0 = p->rec_lb[e], a1 = p->rec_lb[1024 + e];
          float mx = fmaxf(a0, a1);
          float e0 = __expf(a0 - mx), e1 = __expf(a1 - mx);
          float p1 = e1 / (e0 + e1);
          p->lb[e] = 0.f;
          p->lb[1024 + e] = fminf(fmaxf(p1, 0.f), 1.f);
        }
      }
      continue;
    }
  }
  {
    int job = map_job(group, v);
    float* T = (float*)smem;
    const float* src = nullptr; bf16_t* dst = nullptr; int ld = 0;
    f32x4 v0, v1;
#define TR_DECODE(jobid) do { int jb_ = (jobid) - J_FIRST; const int j_ = jb_ / J_TR_PER; int t_ = jb_ % J_TR_PER; int kt_, nt_; \
      if (t_ < J_TR_REC) { kt_ = t_ / 48; nt_ = t_ % 48 + 8; ld = ZN_REC; src = p->rec_w_in + (size_t)j_ * 1024 * ZN_REC; dst = p->WrecT + (size_t)j_ * ZN_REC * 1024; } \
      else if ((t_ -= J_TR_REC) < J_TR_RECO) { kt_ = t_ / 16; nt_ = t_ % 16; ld = 1024; src = p->rec_w_out + (size_t)j_ * 1024 * 1024; dst = p->WrecoT + (size_t)j_ * 1024 * 1024; } \
      else if ((t_ -= J_TR_RECO) < J_TR_ATT) { kt_ = t_ / 40; nt_ = t_ % 40; ld = ZN_ATT; src = p->att_w_in + (size_t)j_ * 1024 * ZN_ATT; dst = p->WattT + (size_t)j_ * ZN_ATT * 1024; } \
      else { t_ -= J_TR_ATT; kt_ = t_ / 16; nt_ = t_ % 16; ld = 1024; src = p->att_w_out + (size_t)j_ * 1024 * 1024; dst = p->WattoT + (size_t)j_ * 1024 * 1024; } \
      src += (size_t)(kt_ * 64) * ld + nt_ * 64; dst += (size_t)(nt_ * 64) * 1024 + kt_ * 64; } while (0)
#define TR_LOAD() do { v0 = *(const f32x4*)(src + (size_t)(tid >> 4) * ld + (tid & 15) * 4); v1 = *(const f32x4*)(src + (size_t)((tid >> 4) + 32) * ld + (tid & 15) * 4); } while (0)
    if (job >= 0) { TR_DECODE(job); TR_LOAD(); }
    while (job >= 0) {
      bf16_t* dcur = dst;
      {
        const int kk = tid >> 4, c4 = tid & 15;
        T[kk * 65 + c4 * 4 + 0] = v0[0]; T[kk * 65 + c4 * 4 + 1] = v0[1]; T[kk * 65 + c4 * 4 + 2] = v0[2]; T[kk * 65 + c4 * 4 + 3] = v0[3];
        T[(kk + 32) * 65 + c4 * 4 + 0] = v1[0]; T[(kk + 32) * 65 + c4 * 4 + 1] = v1[1]; T[(kk + 32) * 65 + c4 * 4 + 2] = v1[2]; T[(kk + 32) * 65 + c4 * 4 + 3] = v1[3];
      }
      lds_barrier();
      v += nb; job = map_job(group, v);
      if (job >= 0) { TR_DECODE(job); TR_LOAD(); }
      {
        const int nn = tid >> 3, k8 = (tid & 7) * 8;
        uint4 o;
        o.x = pk2(T[(k8 + 0) * 65 + nn], T[(k8 + 1) * 65 + nn]);
        o.y = pk2(T[(k8 + 2) * 65 + nn], T[(k8 + 3) * 65 + nn]);
        o.z = pk2(T[(k8 + 4) * 65 + nn], T[(k8 + 5) * 65 + nn]);
        o.w = pk2(T[(k8 + 6) * 65 + nn], T[(k8 + 7) * 65 + nn]);
        *(uint4*)(dcur + (size_t)nn * 1024 + k8) = o;
      }
      lds_barrier();
    }
#undef TR_DECODE
#undef TR_LOAD
  }
  __syncthreads();
}

#define ROW_ST16(BASE, Q) do { _Pragma("unroll") for (int jp_ = 0; jp_ < 2; ++jp_) { \
    const uint2 mine0_ = (Q)[2 * jp_], mine1_ = (Q)[2 * jp_ + 1]; const bool odd_ = lane & 1; \
    const unsigned sx_ = odd_ ? mine0_.x : mine1_.x, sy_ = odd_ ? mine0_.y : mine1_.y; \
    const unsigned rx_ = (unsigned)__builtin_amdgcn_update_dpp(0, (int)sx_, 0xB1, 0xf, 0xf, false), ry_ = (unsigned)__builtin_amdgcn_update_dpp(0, (int)sy_, 0xB1, 0xf, 0xf, false); \
    const uint4 w_ = odd_ ? make_uint4(rx_, ry_, mine1_.x, mine1_.y) : make_uint4(mine0_.x, mine0_.y, rx_, ry_); \
    st16_wt((BASE) + (size_t)row * DM + (lane & ~1) * 4 + (2 * jp_ + (odd_ ? 1 : 0)) * 256, w_); } } while (0)
DI void phase_row(PP p, int li) {
  const int wave = threadIdx.x >> 6, lane = threadIdx.x & 63;
  const int nl = li + 1;
  bf16_t* xz = p->z + (size_t)NTOK * ZN_ATT;
  bf16_t* xy = (bf16_t*)p->out;
  const bf16_t* xsrc = (li == 2) ? xy : xz;
  bf16_t* xdst = (li == 1) ? xy : xz;
  for (int pi = blockIdx.x * 8 + wave; pi < NTOK / 2; pi += gridDim.x * 8) {
    const int row0 = 2 * pi;
    const int mr = (row0 < NCTX) ? 0 : 1 + ((row0 - NCTX) >> 10);
    f32x4 x[2][4], o[2][4], gt[4], npo[4], sh[4], sc[4], npr[4];
#pragma unroll
    for (int r = 0; r < 2; ++r) {
      const int row = row0 + r;
      if (li <= 0) {
        const float* xin = (row < NCTX) ? p->x_prompt + (size_t)row * DM : p->x_sample + (size_t)(row - NCTX) * DM;
#pragma unroll
        for (int j = 0; j < 4; ++j) x[r][j] = *(const f32x4*)(xin + lane * 4 + j * 256);
      } else {
#pragma unroll
        for (int j = 0; j < 4; ++j) {
          const uint2 ux = *(const uint2*)(xsrc + (size_t)row * DM + lane * 4 + j * 256);
          x[r][j] = (f32x4){__uint_as_float(ux.x << 16), __uint_as_float(ux.x & 0xffff0000u), __uint_as_float(ux.y << 16), __uint_as_float(ux.y & 0xffff0000u)};
        }
      }
      if (li >= 0) {
#pragma unroll
        for (int j = 0; j < 4; ++j) {
          const uint2 uo = *(const uint2*)((const bf16_t*)p->oproj + (size_t)row * DM + lane * 4 + j * 256);
          o[r][j] = (f32x4){__uint_as_float(uo.x << 16), __uint_as_float(uo.x & 0xffff0000u), __uint_as_float(uo.y << 16), __uint_as_float(uo.y & 0xffff0000u)};
        }
      }
    }
    if (li >= 0) {
#pragma unroll
      for (int j = 0; j < 4; ++j) {
        gt[j] = *(const f32x4*)(p->mod + ((size_t)li * 9 + mr) * 3072 + 2048 + lane * 4 + j * 256);
        npo[j] = *(const f32x4*)(p->norm_post + li * DM + lane * 4 + j * 256);
      }
    }
    if (nl < 4) {
#pragma unroll
      for (int j = 0; j < 4; ++j) {
        sh[j] = *(const f32x4*)(p->mod + ((size_t)nl * 9 + mr) * 3072 + lane * 4 + j * 256);
        sc[j] = *(const f32x4*)(p->mod + ((size_t)nl * 9 + mr) * 3072 + 1024 + lane * 4 + j * 256);
        npr[j] = *(const f32x4*)(p->norm_pre + nl * DM + lane * 4 + j * 256);
      }
    }
    if (li >= 0) {
      float ss[2];
#pragma unroll
      for (int r = 0; r < 2; ++r) {
        float s_ = 0.f;
#pragma unroll
        for (int j = 0; j < 4; ++j) s_ += o[r][j][0] * o[r][j][0] + o[r][j][1] * o[r][j][1] + o[r][j][2] * o[r][j][2] + o[r][j][3] * o[r][j][3];
        ss[r] = s_;
      }
      ss[0] = wave_sum(ss[0]); ss[1] = wave_sum(ss[1]);
#pragma unroll
      for (int r = 0; r < 2; ++r) {
        const float rstd = rsqrtf(ss[r] * (1.f / DM) + EPS);
#pragma unroll
        for (int j = 0; j < 4; ++j) x[r][j] = x[r][j] + gt[j] * (o[r][j] * rstd * npo[j]);
      }
    }
    uint2 hq[2][4];
    if (nl < 4) {
      float ss[2];
#pragma unroll
      for (int r = 0; r < 2; ++r) {
        float s_ = 0.f;
#pragma unroll
        for (int j = 0; j < 4; ++j) s_ += x[r][j][0] * x[r][j][0] + x[r][j][1] * x[r][j][1] + x[r][j][2] * x[r][j][2] + x[r][j][3] * x[r][j][3];
        ss[r] = s_;
      }
      ss[0] = wave_sum(ss[0]); ss[1] = wave_sum(ss[1]);
#pragma unroll
      for (int r = 0; r < 2; ++r) {
        const float rstd = rsqrtf(ss[r] * (1.f / DM) + EPS);
#pragma unroll
        for (int j = 0; j < 4; ++j) {
          f32x4 hv = x[r][j] * rstd * npr[j] * (sc[j] + 1.f) + sh[j];
          hq[r][j].x = pk2(hv[0], hv[1]); hq[r][j].y = pk2(hv[2], hv[3]);
        }
      }
    }
#pragma unroll
    for (int r = 0; r < 2; ++r) {
      const int row = row0 + r;
      if (li == 3) {
#pragma unroll
        for (int j = 0; j < 4; ++j) *(f32x4*)(p->out + (size_t)row * DM + lane * 4 + j * 256) = x[r][j];
      } else if (li >= 0) {
        uint2 xq[4];
#pragma unroll
        for (int j = 0; j < 4; ++j) { xq[j].x = pk2(x[r][j][0], x[r][j][1]); xq[j].y = pk2(x[r][j][2], x[r][j][3]); }
        ROW_ST16(xdst, xq);
      }
      if (nl < 4) ROW_ST16(p->h, hq[r]);
    }
  }
}

#define LAS __attribute__((address_space(3)))
constexpr int BM = 256, BK = 64, HALF = 128, HTB = HALF * BK * 2, NXCD = 8, WGM = 8;
DI int lds_byte(int r, int c) { const int st = (r >> 4) * 2 + (c >> 5), rr = r & 15, cc = c & 31, ob = rr * 64 + cc * 2; return st * 1024 + (ob ^ (((ob >> 9) & 1) << 5)); }
DI void stage_rc(int b, int& R, int& C) { const int st = b / 1024, sb = b % 1024, swz = sb ^ (((sb >> 9) & 1) << 5); R = (st >> 1) * 16 + swz / 64; C = (st & 1) * 32 + (swz % 64) / 2; }
DI int perm32(int rho) { const int n = rho >> 4, i = rho & 15; return 8 * (i >> 2) + 4 * n + (i & 3); }
struct Unit { int pm, pn; };
struct StaticOrder {
  int nM, nN, nwg, G, c;
  DI void init(int M, int N, int G_, int c_) { nM = M / BM; nN = N / BM; nwg = nM * nN; G = G_; c = c_; }
  DI bool next(int i, Unit& u) const {
    const long L = (long)i * G + c; if (L >= nwg) return false;
    int wgid = (int)L; { const int q = nwg / NXCD, r = nwg % NXCD, xcd = wgid % NXCD, off = wgid / NXCD; wgid = (xcd < r ? xcd * (q + 1) : r * (q + 1) + (xcd - r) * q) + off; }
    const int nig = WGM * nN, gid = wgid / nig, fm = gid * WGM, gsz = (nM - fm) < WGM ? (nM - fm) : WGM;
    u.pm = fm + ((wgid % nig) % gsz); u.pn = (wgid % nig) / gsz; return true;
  }
};
struct EpiF32 {
  static constexpr bool PERM = false;
  float* C; int ldc;
  DI void operator()(const f32x4 (&acc)[2][2][4][2], const Unit& u, int wr, int wc, int fr, int fq) const {
    const int row0 = u.pm * BM + wr * 64 + fr, col0 = u.pn * BM + wc * 32 + 4 * fq;
#pragma unroll
    for (int ai = 0; ai < 2; ++ai)
#pragma unroll
      for (int m = 0; m < 4; ++m) { float* rowp = C + (size_t)(row0 + ai * HALF + m * 16) * ldc + col0;
#pragma unroll
        for (int bj = 0; bj < 2; ++bj)
#pragma unroll
          for (int n = 0; n < 2; ++n) *(f32x4*)(rowp + bj * HALF + n * 16) = acc[ai][bj][m][n]; }
  }
};
struct EpiBf16 {
  static constexpr bool PERM = true;
  bf16_t* O; int ldc;
  DI void operator()(const f32x4 (&acc)[2][2][4][2], const Unit& u, int wr, int wc, int fr, int fq) const {
    const int row0 = u.pm * BM + wr * 64 + fr, col0 = u.pn * BM + wc * 32 + 8 * fq;
#pragma unroll
    for (int ai = 0; ai < 2; ++ai)
#pragma unroll
      for (int m = 0; m < 4; ++m) { bf16_t* rowp = O + (size_t)(row0 + ai * HALF + m * 16) * ldc + col0;
#pragma unroll
        for (int bj = 0; bj < 2; ++bj) { const f32x4 v0 = acc[ai][bj][m][0], v1 = acc[ai][bj][m][1];
          uint4 o; o.x = pk2(v0[0], v0[1]); o.y = pk2(v0[2], v0[3]); o.z = pk2(v1[0], v1[1]); o.w = pk2(v1[2], v1[3]);
          st16_wt(rowp + bj * HALF, o); } }
  }
};

template <class Epi>
DI void phase_gemm(const bf16_t* gA, const bf16_t* gBt, int N, const Epi& E, unsigned char* smem) {
  LAS unsigned char* lds = (LAS unsigned char*)smem;
  StaticOrder S; S.init(NTOK, N, (int)gridDim.x, (int)blockIdx.x);
  const int tid = threadIdx.x, wid = __builtin_amdgcn_readfirstlane(tid >> 6), lane = tid & 63, wr = wid >> 2, wc = wid & 3, fr = lane & 15, fq = lane >> 4;
  constexpr int K = 1024, nt = K / BK;
  unsigned voffA[2], voffB[2];
#pragma unroll
  for (int i = 0; i < 2; ++i) { int R, C; stage_rc(tid * 16 + i * 8192, R, C); const int Rb = Epi::PERM ? ((R & ~31) + perm32(R & 31)) : R;
    voffA[i] = (unsigned)(R * K + C) * 2u; voffB[i] = (unsigned)(Rb * K + C) * 2u; }
  const size_t kstep = (size_t)(BK * 2);
  const size_t hstep = (size_t)HALF * K * 2;
  const size_t tstep = 2 * hstep;
  const unsigned ldsw = (unsigned)wid * 1024u;
  const int aoff = lds_byte(wr * 64 + fr, fq * 8), boff = lds_byte(wc * 32 + fr, fq * 8);
#define PG8_SA(b, h) (((b) * 2 + (h)) * HTB)
#define PG8_SB(b, h) ((4 + (b) * 2 + (h)) * HTB)
#define PG8_STAGE(bufoff, gbase, voff) do { _Pragma("unroll") for (int _i = 0; _i < 2; ++_i) \
    __builtin_amdgcn_global_load_lds((const unsigned*)((const char*)(gbase) + (voff)[_i]), (LAS unsigned*)(lds + (bufoff) + ldsw + _i * 8192), 16, 0, 0); } while (0)
#define PG8_LDA(dst, b, h) do { _Pragma("unroll") for (int m = 0; m < 4; ++m) _Pragma("unroll") for (int k = 0; k < 2; ++k) dst[m][k] = *(const LAS bf16x8*)(lds + PG8_SA(b, h) + aoff + m * 2048 + k * 1024); } while (0)
#define PG8_LDB(dst, b, h) do { _Pragma("unroll") for (int n = 0; n < 2; ++n) _Pragma("unroll") for (int k = 0; k < 2; ++k) dst[n][k] = *(const LAS bf16x8*)(lds + PG8_SB(b, h) + boff + n * 2048 + k * 1024); } while (0)
#define PG8_MMA(ai, bj, At, Bt) do { __builtin_amdgcn_s_setprio(1); _Pragma("unroll") for (int m = 0; m < 4; ++m) _Pragma("unroll") for (int n = 0; n < 2; ++n) _Pragma("unroll") for (int k = 0; k < 2; ++k) \
    acc[ai][bj][m][n] = __builtin_amdgcn_mfma_f32_16x16x32_bf16(Bt[n][k], At[m][k], acc[ai][bj][m][n], 0, 0, 0); __builtin_amdgcn_s_setprio(0); } while (0)
#define PG8_WAIT_V(n) asm volatile("s_waitcnt vmcnt(" #n ")" ::: "memory")
#define PG8_WAIT_L(n) asm volatile("s_waitcnt lgkmcnt(" #n ")" ::: "memory")
#define PG8_BAR __builtin_amdgcn_s_barrier()
#define PG8_SCHED __builtin_amdgcn_sched_barrier(0)
  Unit cur, nxt; int ui = 0;
  if (S.next(0, cur)) {
    f32x4 acc[2][2][4][2];
#pragma unroll
    for (int a = 0; a < 2; ++a)
#pragma unroll
      for (int b = 0; b < 2; ++b)
#pragma unroll
        for (int m = 0; m < 4; ++m)
#pragma unroll
          for (int n = 0; n < 2; ++n) acc[a][b][m][n] = (f32x4){0.f, 0.f, 0.f, 0.f};
    bf16x8 At[4][2], B0[2][2], B1[2][2];
    const char* cA = (const char*)gA + (size_t)cur.pm * tstep; const char* cB = (const char*)gBt + (size_t)cur.pn * tstep;
    PG8_STAGE(PG8_SB(0, 0), cB, voffB); PG8_STAGE(PG8_SA(0, 0), cA, voffA); PG8_STAGE(PG8_SB(0, 1), cB + hstep, voffB); PG8_STAGE(PG8_SA(0, 1), cA + hstep, voffA);
    if (wr == 1) PG8_BAR;
    PG8_WAIT_V(4); PG8_BAR;
    PG8_STAGE(PG8_SB(1, 0), cB + kstep, voffB); PG8_STAGE(PG8_SA(1, 0), cA + kstep, voffA); PG8_STAGE(PG8_SB(1, 1), cB + hstep + kstep, voffB);
    PG8_WAIT_V(6); PG8_BAR;
    for (;;) {
      const bool has_next = S.next(ui + 1, nxt);
      const char* nA = has_next ? (const char*)gA + (size_t)nxt.pm * tstep : cA; const char* nB = has_next ? (const char*)gBt + (size_t)nxt.pn * tstep : cB;
      for (int t = 0; t < nt; t += 2) {
        const bool last = (t == nt - 2);
        const char* a1 = cA + (size_t)(t + 1) * kstep;
        const char* a2 = last ? nA : cA + (size_t)(t + 2) * kstep; const char* b2 = last ? nB : cB + (size_t)(t + 2) * kstep;
        const char* a3 = a2 + kstep; const char* b3 = b2 + kstep;
        PG8_LDB(B0, 0, 0); PG8_SCHED; PG8_LDA(At, 0, 0); PG8_STAGE(PG8_SA(1, 1), a1 + hstep, voffA);
        PG8_WAIT_L(8); PG8_BAR; PG8_WAIT_L(0); PG8_MMA(0, 0, At, B0); PG8_BAR; PG8_SCHED;
        PG8_LDB(B1, 0, 1); PG8_STAGE(PG8_SB(0, 0), b2, voffB);
        PG8_BAR; PG8_WAIT_L(0); PG8_MMA(0, 1, At, B1); PG8_BAR;
        PG8_LDA(At, 0, 1); PG8_STAGE(PG8_SA(0, 0), a2, voffA);
        PG8_BAR; PG8_WAIT_L(0); PG8_MMA(1, 0, At, B0); PG8_BAR; PG8_SCHED;
        PG8_STAGE(PG8_SB(0, 1), b2 + hstep, voffB);
        PG8_WAIT_V(6); PG8_BAR; PG8_MMA(1, 1, At, B1); PG8_BAR;
        PG8_LDB(B0, 1, 0); PG8_SCHED; PG8_LDA(At, 1, 0); PG8_STAGE(PG8_SA(0, 1), a2 + hstep, voffA);
        PG8_WAIT_L(8); PG8_BAR; PG8_WAIT_L(0); PG8_MMA(0, 0, At, B0); PG8_BAR; PG8_SCHED;
        PG8_LDB(B1, 1, 1); PG8_STAGE(PG8_SB(1, 0), b3, voffB);
        PG8_BAR; PG8_WAIT_L(0); PG8_MMA(0, 1, At, B1); PG8_BAR;
        PG8_LDA(At, 1, 1); PG8_STAGE(PG8_SA(1, 0), a3, voffA);
        PG8_BAR; PG8_WAIT_L(0); PG8_MMA(1, 0, At, B0); PG8_BAR; PG8_SCHED;
        PG8_STAGE(PG8_SB(1, 1), b3 + hstep, voffB);
        PG8_WAIT_V(6); PG8_BAR; PG8_MMA(1, 1, At, B1); PG8_BAR;
      }
      E(acc, cur, wr, wc, fr, fq);
      if (!has_next) break;
#pragma unroll
      for (int a = 0; a < 2; ++a)
#pragma unroll
        for (int b = 0; b < 2; ++b)
#pragma unroll
          for (int m = 0; m < 4; ++m)
#pragma unroll
            for (int n = 0; n < 2; ++n) acc[a][b][m][n] = (f32x4){0.f, 0.f, 0.f, 0.f};
      cur = nxt; cA = nA; cB = nB; ++ui;
    }
    PG8_WAIT_V(0);
    if (wr == 0) PG8_BAR;
    PG8_BAR;
  }
  __syncthreads();
#undef PG8_SA
#undef PG8_SB
#undef PG8_STAGE
#undef PG8_LDA
#undef PG8_LDB
#undef PG8_MMA
}

constexpr int REC_BYTES = 28672, REC_QF = 0, REC_KF = 8192, REC_VF = 16384, REC_PF = 24576, REC_AL = 26624;
constexpr int N_REC_A = 877;
DI unsigned char* rec_ptr(PP p, int it) {
  return (it < N_REC_A) ? ((unsigned char*)p->oproj + (size_t)NTOK * 512 * 4 + (size_t)it * REC_BYTES)
                        : ((unsigned char*)p->h + (size_t)(it - N_REC_A) * REC_BYTES);
}
struct PrepSlot { float* LF; bf16_t *Qin, *Qt, *Kt, *KoT, *VT; float *AL, *EM, *ELM; };
DI PrepSlot prep_slot(unsigned char* smem, int s) {
  unsigned char* b = smem + s * 61440;
  PrepSlot L;
  L.LF = (float*)b;
  L.Qin = (bf16_t*)(b + 16384);
  L.Qt = L.Qin + 32 * 136;
  L.Kt = L.Qt + 32 * 136;
  L.KoT = L.Kt + 32 * 136;
  L.VT = L.KoT + 32 * 136;
  L.AL = (float*)(L.VT + 32 * 136);
  L.EM = L.AL + 128;
  L.ELM = L.EM + 128;
  return L;
}
struct PrepRegs { bf16x8 q8, f8, v8; f32x4 lwa, lwb; };
DI void prep_load(PP p, int j, int item, int t, int d0, PrepRegs& R) {
  const int dir = item & 1, hd = (item >> 1) & 3, ck = item >> 3;
  const bf16_t* zr = p->z + (size_t)(ck * 32 + (dir ? 31 - t : t)) * ZN_REC + hd * 128 + d0;
  R.q8 = *(const bf16x8*)(zr + 1024); R.f8 = *(const bf16x8*)(zr + (dir ? 2048 : 1536)); R.v8 = *(const bf16x8*)(zr + 2560);
  const float* lp = p->lb + (j * 2 + dir) * 512 + hd * 128 + d0;
  R.lwa = *(const f32x4*)lp; R.lwb = *(const f32x4*)(lp + 4);
}
DI void prep_stepA(const PrepSlot& L, const PrepRegs& R, int t, int d0, float (&sq)[8], float (&kk)[8]) {
  float lf[8];
#pragma unroll
  for (int i = 0; i < 8; ++i) {
    const float lw = (i < 4) ? R.lwa[i & 3] : R.lwb[i & 3];
    const float zf = bfs(R.f8[i]);
    const float sg = __builtin_amdgcn_rcpf(1.f + __builtin_amdgcn_exp2f(-1.4426950408889634f * zf));
    float f = lw + (1.f - lw) * sg;
    f = fminf(fmaxf(f, 1e-6f), 1.f);
    lf[i] = __builtin_amdgcn_logf(f);
    kk[i] = 1.f - f;
    sq[i] = silu_f(bfs(R.q8[i]));
  }
  *(f32x4*)(L.LF + t * 128 + d0) = (f32x4){lf[0], lf[1], lf[2], lf[3]};
  *(f32x4*)(L.LF + t * 128 + d0 + 4) = (f32x4){lf[4], lf[5], lf[6], lf[7]};
}
DI void prep_stepC(const PrepSlot& L, bf16x8 vcur, int t, int d0, const float (&sq)[8], const float (&kk)[8]) {
  f32x4 b0 = *(f32x4*)(L.LF + t * 128 + d0), b1 = *(f32x4*)(L.LF + t * 128 + d0 + 4);
  f32x4 m0 = *(f32x4*)(L.LF + 15 * 128 + d0), m1 = *(f32x4*)(L.LF + 15 * 128 + d0 + 4);
  f32x4 em0 = *(f32x4*)(L.EM + d0), em1 = *(f32x4*)(L.EM + d0 + 4);
  f32x4 el0 = *(f32x4*)(L.ELM + d0), el1 = *(f32x4*)(L.ELM + d0 + 4);
  float qi[8], qt[8], kt[8], ko[8];
#pragma unroll
  for (int i = 0; i < 8; ++i) {
    const float b = (i < 4) ? b0[i & 3] : b1[i & 3];
    const float bm = (i < 4) ? m0[i & 3] : m1[i & 3];
    const float em = (i < 4) ? em0[i & 3] : em1[i & 3];
    const float el = (i < 4) ? el0[i & 3] : el1[i & 3];
    qt[i] = sq[i] * __builtin_amdgcn_exp2f(b - bm);
    kt[i] = kk[i] * __builtin_amdgcn_exp2f(bm - b);
    qi[i] = qt[i] * em;
    ko[i] = kt[i] * el;
  }
  uint4 o;
  o.x = pk2(ko[0], ko[1]); o.y = pk2(ko[2], ko[3]); o.z = pk2(ko[4], ko[5]); o.w = pk2(ko[6], ko[7]);
  *(uint4*)(L.KoT + t * 136 + d0) = o;
  *(bf16x8*)(L.VT + t * 136 + d0) = vcur;
  o.x = pk2(qi[0], qi[1]); o.y = pk2(qi[2], qi[3]); o.z = pk2(qi[4], qi[5]); o.w = pk2(qi[6], qi[7]);
  *(uint4*)(L.Qin + t * 136 + d0) = o;
  o.x = pk2(qt[0], qt[1]); o.y = pk2(qt[2], qt[3]); o.z = pk2(qt[4], qt[5]); o.w = pk2(qt[6], qt[7]);
  *(uint4*)(L.Qt + t * 136 + d0) = o;
  o.x = pk2(kt[0], kt[1]); o.y = pk2(kt[2], kt[3]); o.z = pk2(kt[4], kt[5]); o.w = pk2(kt[6], kt[7]);
  *(uint4*)(L.Kt + t * 136 + d0) = o;
}
DI void prep_copyout(const PrepSlot& L, unsigned char* rec, int tid, int wave, int lane, int c, int hh) {
  const int f = wave, fd = f >> 1, fk = f & 1;
  {
    const bf16_t* s0 = L.Qin + c * 136 + 32 * fd + 16 * fk + 4 * hh;
    uint2 x0 = *(const uint2*)s0, x1 = *(const uint2*)(s0 + 8);
    st16_wt(rec + REC_QF + (f * 64 + lane) * 16, make_uint4(x0.x, x0.y, x1.x, x1.y));
  }
  {
    const bf16_t* k0 = L.KoT + (16 * fk + 4 * hh) * 136 + 32 * fd + c;
    const bf16_t* v0 = L.VT + (16 * fk + 4 * hh) * 136 + 32 * fd + c;
    uint4 ok, ov;
    ok.x = (unsigned)k0[0 * 136] | ((unsigned)k0[1 * 136] << 16); ok.y = (unsigned)k0[2 * 136] | ((unsigned)k0[3 * 136] << 16);
    ok.z = (unsigned)k0[8 * 136] | ((unsigned)k0[9 * 136] << 16); ok.w = (unsigned)k0[10 * 136] | ((unsigned)k0[11 * 136] << 16);
    ov.x = (unsigned)v0[0 * 136] | ((unsigned)v0[1 * 136] << 16); ov.y = (unsigned)v0[2 * 136] | ((unsigned)v0[3 * 136] << 16);
    ov.z = (unsigned)v0[8 * 136] | ((unsigned)v0[9 * 136] << 16); ov.w = (unsigned)v0[10 * 136] | ((unsigned)v0[11 * 136] << 16);
    st16_wt(rec + REC_KF + (f * 64 + lane) * 16, ok);
    st16_wt(rec + REC_VF + (f * 64 + lane) * 16, ov);
  }
  if (tid < 32) *(f32x4*)(rec + REC_AL + tid * 16) = *(const f32x4*)(L.AL + tid * 4);
}
DI void prep_intra(const PrepSlot& L, unsigned char* rec, int lane, int c, int hh) {
  f32x16 at;
#pragma unroll
  for (int q = 0; q < 16; ++q) at[q] = 0.f;
#pragma unroll
  for (int ks = 0; ks < 8; ++ks) {
    bf16x8 a = *(const bf16x8*)(L.Kt + c * 136 + ks * 16 + hh * 8);
    bf16x8 b = *(const bf16x8*)(L.Qt + c * 136 + ks * 16 + hh * 8);
    at = mfma32(a, b, at);
  }
#pragma unroll
  for (int q = 0; q < 16; ++q) {
    int sr = 8 * (q >> 2) + 4 * hh + (q & 3);
    if (sr > c) at[q] = 0.f;
  }
  st16_wt(rec + REC_PF + lane * 16, __builtin_bit_cast(uint4, pack8(at, 0)));
  st16_wt(rec + REC_PF + (64 + lane) * 16, __builtin_bit_cast(uint4, pack8(at, 1)));
}
DI void scan_prep(PP p, int j, unsigned char* smem) {
  const int tid = threadIdx.x, wave = tid >> 6, lane = tid & 63, c = lane & 31, hh = lane >> 5;
  const PrepSlot L0 = prep_slot(smem, 0), L1 = prep_slot(smem, 1);
  const int t = tid >> 4, d0 = (tid & 15) * 8;
  const int G = gridDim.x;
  int pr = blockIdx.x;
  if (pr >= 1536) return;
  PrepRegs R0, R1;
  prep_load(p, j, 2 * pr, t, d0, R0); prep_load(p, j, 2 * pr + 1, t, d0, R1);
  for (; pr < 1536; pr += G) {
    float sq0[8], kk0[8], sq1[8], kk1[8];
    const bf16x8 v0 = R0.v8, v1 = R1.v8;
    prep_stepA(L0, R0, t, d0, sq0, kk0);
    prep_stepA(L1, R1, t, d0, sq1, kk1);
    if (pr + G < 1536) { prep_load(p, j, 2 * (pr + G), t, d0, R0); prep_load(p, j, 2 * (pr + G) + 1, t, d0, R1); }
    lds_barrier();
    if (tid < 256) {
      const PrepSlot& L = (tid < 128) ? L0 : L1;
      const int d = tid & 127;
      float run = 0.f, bmid = 0.f;
#pragma unroll
      for (int tt = 0; tt < 32; ++tt) { run += L.LF[tt * 128 + d]; L.LF[tt * 128 + d] = run; if (tt == 15) bmid = run; }
      L.AL[d] = __builtin_amdgcn_exp2f(run);
      L.EM[d] = __builtin_amdgcn_exp2f(bmid);
      L.ELM[d] = __builtin_amdgcn_exp2f(run - bmid);
    }
    lds_barrier();
    prep_stepC(L0, v0, t, d0, sq0, kk0);
    prep_stepC(L1, v1, t, d0, sq1, kk1);
    lds_barrier();
    unsigned char* rec0 = rec_ptr(p, 2 * pr);
    unsigned char* rec1 = rec_ptr(p, 2 * pr + 1);
    prep_copyout(L0, rec0, tid, wave, lane, c, hh);
    prep_copyout(L1, rec1, tid, wave, lane, c, hh);
    if (wave == 0) prep_intra(L0, rec0, lane, c, hh);
    else if (wave == 1) prep_intra(L1, rec1, lane, c, hh);
    lds_barrier();
  }
}

DI void scan_chain_item(PP p, int j, int item, unsigned char* smem) {
  int s, hd, dir;
  if (item < 64) { s = 16 + (item >> 3); hd = (item >> 1) & 3; dir = item & 1; }
  else { int it = item - 64; s = it >> 3; hd = (it >> 1) & 3; dir = it & 1; }
  const int L = (s < 16) ? 256 : 1024;
  const int row0 = (s < 16) ? s * 256 : NCTX + (s - 16) * 1024;
  const int tid = threadIdx.x, wave = tid >> 6, lane = tid & 63, c = lane & 31, hh = lane >> 5;
  const int nch = L / 32, ck0 = row0 / 32;
  bf16_t* obuf = (bf16_t*)p->oproj + (dir ? (size_t)NTOK * 512 : 0);
#define REC_OF(n) rec_ptr(p, (((ck0 + (dir ? nch - 1 - (n) : (n))) * 4 + hd) * 2 + dir))
  if (wave >= 4) {
    const int lt = tid - 256;
    uint4 g0, g1, g2, g3, g4, g5, g6;
#define RG_LOAD(srcp) do { const unsigned char* s_ = (srcp) + lt * 16; g0 = *(const uint4*)(s_); g1 = *(const uint4*)(s_ + 4096); g2 = *(const uint4*)(s_ + 8192); \
    g3 = *(const uint4*)(s_ + 12288); g4 = *(const uint4*)(s_ + 16384); g5 = *(const uint4*)(s_ + 20480); g6 = *(const uint4*)(s_ + 24576); } while (0)
#define RG_STORE(dstp) do { unsigned char* d_ = (dstp) + lt * 16; *(uint4*)(d_) = g0; *(uint4*)(d_ + 4096) = g1; *(uint4*)(d_ + 8192) = g2; \
    *(uint4*)(d_ + 12288) = g3; *(uint4*)(d_ + 16384) = g4; *(uint4*)(d_ + 20480) = g5; *(uint4*)(d_ + 24576) = g6; } while (0)
    RG_LOAD(REC_OF(0));
    RG_STORE(smem);
    if (nch > 1) RG_LOAD(REC_OF(1));
    lds_barrier();
    for (int n = 0; n < nch; ++n) {
      if (n + 1 < nch) {
        RG_STORE(smem + ((n + 1) & 1) * REC_BYTES);
        if (n + 2 < nch) RG_LOAD(REC_OF(n + 2));
      }
      lds_barrier();
    }
#undef RG_LOAD
#undef RG_STORE
  } else {
    const int vs = wave;
    __builtin_amdgcn_s_setprio(3);
    f32x16 S[4];
    if (s >= 16) {
      const float* sp = p->state + ((((size_t)(s - 16) * 2 + j) * 2 + dir) * 4 + hd) * 16384;
#pragma unroll
      for (int dt = 0; dt < 4; ++dt)
#pragma unroll
        for (int q = 0; q < 16; ++q) {
          int d = 32 * dt + 8 * (q >> 2) + 4 * hh + (q & 3);
          S[dt][q] = sp[d * 128 + vs * 32 + c];
        }
    } else {
#pragma unroll
      for (int dt = 0; dt < 4; ++dt)
#pragma unroll
        for (int q = 0; q < 16; ++q) S[dt][q] = 0.f;
    }
    lds_barrier();
    for (int n = 0; n < nch; ++n) {
      const unsigned char* rb = smem + (n & 1) * REC_BYTES;
      bf16x8 qf[8];
      const bf16x8 vf0 = *(const bf16x8*)(rb + REC_VF + ((vs * 2 + 0) * 64 + lane) * 16);
      const bf16x8 vf1 = *(const bf16x8*)(rb + REC_VF + ((vs * 2 + 1) * 64 + lane) * 16);
      const bf16x8 pf0 = *(const bf16x8*)(rb + REC_PF + lane * 16);
      const bf16x8 pf1 = *(const bf16x8*)(rb + REC_PF + (64 + lane) * 16);
#pragma unroll
      for (int f = 0; f < 8; ++f) qf[f] = *(const bf16x8*)(rb + REC_QF + (f * 64 + lane) * 16);
      __builtin_amdgcn_sched_barrier(0);
      f32x16 o;
#pragma unroll
      for (int q = 0; q < 16; ++q) o[q] = 0.f;
      o = mfma32(pf0, vf0, o);
      o = mfma32(pf1, vf1, o);
#pragma unroll
      for (int f = 0; f < 8; ++f) o = mfma32(qf[f], pack8(S[f >> 1], f & 1), o);
      __builtin_amdgcn_sched_barrier(0);
      {
        const int ck = ck0 + (dir ? nch - 1 - n : n);
#pragma unroll
        for (int q = 0; q < 16; ++q) {
          const int tr = 8 * (q >> 2) + 4 * hh + (q & 3);
          const int row = ck * 32 + (dir ? 31 - tr : tr);
          obuf[(size_t)row * 512 + hd * 128 + vs * 32 + c] = (bf16_t)pk2(o[q], 0.f);
        }
      }
#pragma unroll
      for (int half = 0; half < 2; ++half) {
        bf16x8 kf[4];
        f32x4 al[8];
#pragma unroll
        for (int f = 0; f < 4; ++f) kf[f] = *(const bf16x8*)(rb + REC_KF + ((half * 4 + f) * 64 + lane) * 16);
#pragma unroll
        for (int d2 = 0; d2 < 2; ++d2)
#pragma unroll
          for (int g = 0; g < 4; ++g) al[d2 * 4 + g] = *(const f32x4*)(rb + REC_AL + (32 * (half * 2 + d2) + 8 * g + 4 * hh) * 4);
        __builtin_amdgcn_sched_barrier(0);
#pragma unroll
        for (int d2 = 0; d2 < 2; ++d2) {
          const int dt = half * 2 + d2;
#pragma unroll
          for (int g = 0; g < 4; ++g) {
            const f32x4 a4 = al[d2 * 4 + g];
            S[dt][4 * g + 0] *= a4[0]; S[dt][4 * g + 1] *= a4[1]; S[dt][4 * g + 2] *= a4[2]; S[dt][4 * g + 3] *= a4[3];
          }
          S[dt] = mfma32(kf[d2 * 2 + 0], vf0, S[dt]);
          S[dt] = mfma32(kf[d2 * 2 + 1], vf1, S[dt]);
        }
        __builtin_amdgcn_sched_barrier(0);
      }
      lds_barrier();
    }
    __builtin_amdgcn_s_setprio(0);
    if (s < 16) {
      float* op = p->out + (size_t)NTOK * DM + ((((size_t)s * 2 + j) * 2 + dir) * 4 + hd) * 16384;
#pragma unroll
      for (int dt = 0; dt < 4; ++dt)
#pragma unroll
        for (int q = 0; q < 16; ++q) {
          int d = 32 * dt + 8 * (q >> 2) + 4 * hh + (q & 3);
          op[d * 128 + vs * 32 + c] = S[dt][q];
        }
    }
  }
#undef REC_OF
  __syncthreads();
}

constexpr int R64_BYTES = 57344, R64_QF = 0, R64_KF = 16384, R64_VF = 32768, R64_PF = 49152, R64_AL = 55296;
constexpr int N_R64_A = 438;
DI unsigned char* rec64_ptr(PP p, int it) {
  return (it < N_R64_A) ? ((unsigned char*)p->oproj + (size_t)NTOK * 512 * 4 + (size_t)it * R64_BYTES)
                        : ((unsigned char*)p->h + (size_t)(it - N_R64_A) * R64_BYTES);
}
struct Prep64 { float* LF; bf16_t *Qin, *Qt, *Kt, *Ko, *Vr; float *AL, *EM, *ELM; };
DI void prep64_load(PP p, int j, int item, int t, int d0, PrepRegs& R) {
  const int dir = item & 1, hd = (item >> 1) & 3, ck = item >> 3;
  const bf16_t* zr = p->z + (size_t)(ck * 64 + (dir ? 63 - t : t)) * ZN_REC + hd * 128 + d0;
  R.q8 = *(const bf16x8*)(zr + 1024); R.f8 = *(const bf16x8*)(zr + (dir ? 2048 : 1536)); R.v8 = *(const bf16x8*)(zr + 2560);
  const float* lp = p->lb + (j * 2 + dir) * 512 + hd * 128 + d0;
  R.lwa = *(const f32x4*)lp; R.lwb = *(const f32x4*)(lp + 4);
}
DI void prep64_stepA(const Prep64& L, const PrepRegs& R, int t, int d0, float (&sq)[8], float (&kk)[8]) {
  float lf[8];
#pragma unroll
  for (int i = 0; i < 8; ++i) {
    const float lw = (i < 4) ? R.lwa[i & 3] : R.lwb[i & 3];
    const float zf = bfs(R.f8[i]);
    const float sg = __builtin_amdgcn_rcpf(1.f + __builtin_amdgcn_exp2f(-1.4426950408889634f * zf));
    float f = lw + (1.f - lw) * sg;
    f = fminf(fmaxf(f, 1e-6f), 1.f);
    lf[i] = __builtin_amdgcn_logf(f);
    kk[i] = 1.f - f;
    sq[i] = silu_f(bfs(R.q8[i]));
  }
  *(f32x4*)(L.LF + t * 128 + d0) = (f32x4){lf[0], lf[1], lf[2], lf[3]};
  *(f32x4*)(L.LF + t * 128 + d0 + 4) = (f32x4){lf[4], lf[5], lf[6], lf[7]};
}
DI void prep64_stepC(const Prep64& L, bf16x8 vcur, int t, int d0, const float (&sq)[8], const float (&kk)[8]) {
  f32x4 b0 = *(f32x4*)(L.LF + t * 128 + d0), b1 = *(f32x4*)(L.LF + t * 128 + d0 + 4);
  f32x4 m0 = *(f32x4*)(L.LF + 31 * 128 + d0), m1 = *(f32x4*)(L.LF + 31 * 128 + d0 + 4);
  f32x4 em0 = *(f32x4*)(L.EM + d0), em1 = *(f32x4*)(L.EM + d0 + 4);
  f32x4 el0 = *(f32x4*)(L.ELM + d0), el1 = *(f32x4*)(L.ELM + d0 + 4);
  float qi[8], qt[8], kt[8], ko[8];
#pragma unroll
  for (int i = 0; i < 8; ++i) {
    const float b = (i < 4) ? b0[i & 3] : b1[i & 3];
    const float bm = (i < 4) ? m0[i & 3] : m1[i & 3];
    const float em = (i < 4) ? em0[i & 3] : em1[i & 3];
    const float el = (i < 4) ? el0[i & 3] : el1[i & 3];
    qt[i] = sq[i] * __builtin_amdgcn_exp2f(b - bm);
    kt[i] = kk[i] * __builtin_amdgcn_exp2f(bm - b);
    qi[i] = qt[i] * em;
    ko[i] = kt[i] * el;
  }
  uint4 o;
  o.x = pk2(qi[0], qi[1]); o.y = pk2(qi[2], qi[3]); o.z = pk2(qi[4], qi[5]); o.w = pk2(qi[6], qi[7]);
  *(uint4*)(L.Qin + t * 136 + d0) = o;
  o.x = pk2(qt[0], qt[1]); o.y = pk2(qt[2], qt[3]); o.z = pk2(qt[4], qt[5]); o.w = pk2(qt[6], qt[7]);
  *(uint4*)(L.Qt + t * 136 + d0) = o;
  o.x = pk2(kt[0], kt[1]); o.y = pk2(kt[2], kt[3]); o.z = pk2(kt[4], kt[5]); o.w = pk2(kt[6], kt[7]);
  *(uint4*)(L.Kt + t * 136 + d0) = o;
  o.x = pk2(ko[0], ko[1]); o.y = pk2(ko[2], ko[3]); o.z = pk2(ko[4], ko[5]); o.w = pk2(ko[6], ko[7]);
  *(uint4*)(L.Ko + t * 136 + d0) = o;
  *(bf16x8*)(L.Vr + t * 136 + d0) = vcur;
}
DI void scan_prep64(PP p, int j, unsigned char* smem) {
  const int tid = threadIdx.x, wave = tid >> 6, lane = tid & 63, c = lane & 31, hh = lane >> 5;
  Prep64 L;
  L.LF = (float*)smem;
  L.Qin = (bf16_t*)(smem + 32768);
  L.Qt = L.Qin + 64 * 136; L.Kt = L.Qt + 64 * 136; L.Ko = L.Kt + 64 * 136; L.Vr = L.Ko + 64 * 136;
  L.AL = (float*)(L.Vr + 64 * 136); L.EM = L.AL + 128; L.ELM = L.EM + 128;
  const int t0 = tid >> 4, t1 = t0 + 32, d0 = (tid & 15) * 8;
  const int G = gridDim.x;
  int item = blockIdx.x;
  if (item >= 1536) return;
  PrepRegs R0, R1;
  prep64_load(p, j, item, t0, d0, R0); prep64_load(p, j, item, t1, d0, R1);
  for (; item < 1536; item += G) {
    float sq0[8], kk0[8], sq1[8], kk1[8];
    const bf16x8 v0 = R0.v8, v1 = R1.v8;
    prep64_stepA(L, R0, t0, d0, sq0, kk0);
    prep64_stepA(L, R1, t1, d0, sq1, kk1);
    if (item + G < 1536) { prep64_load(p, j, item + G, t0, d0, R0); prep64_load(p, j, item + G, t1, d0, R1); }
    lds_barrier();
    if (tid < 128) {
      float run = 0.f, bmid = 0.f;
#pragma unroll
      for (int tt = 0; tt < 64; ++tt) { run += L.LF[tt * 128 + tid]; L.LF[tt * 128 + tid] = run; if (tt == 31) bmid = run; }
      L.AL[tid] = __builtin_amdgcn_exp2f(run);
      L.EM[tid] = __builtin_amdgcn_exp2f(bmid);
      L.ELM[tid] = __builtin_amdgcn_exp2f(run - bmid);
    }
    lds_barrier();
    prep64_stepC(L, v0, t0, d0, sq0, kk0);
    prep64_stepC(L, v1, t1, d0, sq1, kk1);
    lds_barrier();
    unsigned char* rec = rec64_ptr(p, item);
#pragma unroll
    for (int e = 0; e < 2; ++e) {
      const int f = wave * 2 + e;
      {
        const int mT = f >> 3, dt = (f >> 1) & 3, k2 = f & 1;
        const bf16_t* s0 = L.Qin + (32 * mT + c) * 136 + 32 * dt + 16 * k2 + 4 * hh;
        uint2 x0 = *(const uint2*)s0, x1 = *(const uint2*)(s0 + 8);
        st16_wt(rec + R64_QF + (f * 64 + lane) * 16, make_uint4(x0.x, x0.y, x1.x, x1.y));
      }
      {
        const int fd = f >> 2, ks = f & 3;
        const bf16_t* k0 = L.Ko + (16 * ks + 4 * hh) * 136 + 32 * fd + c;
        const bf16_t* w0 = L.Vr + (16 * ks + 4 * hh) * 136 + 32 * fd + c;
        uint4 ok, ov;
        ok.x = (unsigned)k0[0 * 136] | ((unsigned)k0[1 * 136] << 16); ok.y = (unsigned)k0[2 * 136] | ((unsigned)k0[3 * 136] << 16);
        ok.z = (unsigned)k0[8 * 136] | ((unsigned)k0[9 * 136] << 16); ok.w = (unsigned)k0[10 * 136] | ((unsigned)k0[11 * 136] << 16);
        ov.x = (unsigned)w0[0 * 136] | ((unsigned)w0[1 * 136] << 16); ov.y = (unsigned)w0[2 * 136] | ((unsigned)w0[3 * 136] << 16);
        ov.z = (unsigned)w0[8 * 136] | ((unsigned)w0[9 * 136] << 16); ov.w = (unsigned)w0[10 * 136] | ((unsigned)w0[11 * 136] << 16);
        st16_wt(rec + R64_KF + (f * 64 + lane) * 16, ok);
        st16_wt(rec + R64_VF + (f * 64 + lane) * 16, ov);
      }
    }
    if (tid < 32) *(f32x4*)(rec + R64_AL + tid * 16) = *(const f32x4*)(L.AL + tid * 4);
    if (wave < 3) {
      const int sT = (wave == 2) ? 1 : 0, tT = (wave == 0) ? 0 : 1;
      f32x16 at;
#pragma unroll
      for (int q = 0; q < 16; ++q) at[q] = 0.f;
#pragma unroll
      for (int ks = 0; ks < 8; ++ks) {
        bf16x8 a = *(const bf16x8*)(L.Kt + (32 * sT + c) * 136 + ks * 16 + hh * 8);
        bf16x8 b = *(const bf16x8*)(L.Qt + (32 * tT + c) * 136 + ks * 16 + hh * 8);
        at = mfma32(a, b, at);
      }
      if (sT == tT) {
#pragma unroll
        for (int q = 0; q < 16; ++q) {
          int sr = 8 * (q >> 2) + 4 * hh + (q & 3);
          if (sr > c) at[q] = 0.f;
        }
      }
      st16_wt(rec + R64_PF + ((wave * 2 + 0) * 64 + lane) * 16, __builtin_bit_cast(uint4, pack8(at, 0)));
      st16_wt(rec + R64_PF + ((wave * 2 + 1) * 64 + lane) * 16, __builtin_bit_cast(uint4, pack8(at, 1)));
    }
    lds_barrier();
  }
}

DI void scan_chain_item64(PP p, int j, int item, unsigned char* smem) {
  int s, hd, dir;
  if (item < 64) { s = 16 + (item >> 3); hd = (item >> 1) & 3; dir = item & 1; }
  else { int it = item - 64; s = it >> 3; hd = (it >> 1) & 3; dir = it & 1; }
  const int L = (s < 16) ? 256 : 1024;
  const int row0 = (s < 16) ? s * 256 : NCTX + (s - 16) * 1024;
  const int tid = threadIdx.x, wave = tid >> 6, lane = tid & 63, c = lane & 31, hh = lane >> 5;
  const int nch = L / 64, ck0 = row0 / 64;
  bf16_t* obuf = (bf16_t*)p->oproj + (dir ? (size_t)NTOK * 512 : 0);
#define REC_OF(n) rec64_ptr(p, (((ck0 + (dir ? nch - 1 - (n) : (n))) * 4 + hd) * 2 + dir))
  if (wave >= 4) {
    const int lt = tid - 256;
    uint4 g0, g1, g2, g3, g4, g5, g6, g7, g8, g9, g10, g11, g12, g13;
#define RG_LOAD(srcp) do { const unsigned char* s_ = (srcp) + lt * 16; g0 = *(const uint4*)(s_); g1 = *(const uint4*)(s_ + 4096); g2 = *(const uint4*)(s_ + 8192); \
    g3 = *(const uint4*)(s_ + 12288); g4 = *(const uint4*)(s_ + 16384); g5 = *(const uint4*)(s_ + 20480); g6 = *(const uint4*)(s_ + 24576); \
    g7 = *(const uint4*)(s_ + 28672); g8 = *(const uint4*)(s_ + 32768); g9 = *(const uint4*)(s_ + 36864); g10 = *(const uint4*)(s_ + 40960); \
    g11 = *(const uint4*)(s_ + 45056); g12 = *(const uint4*)(s_ + 49152); g13 = *(const uint4*)(s_ + 53248); } while (0)
#define RG_STORE(dstp) do { unsigned char* d_ = (dstp) + lt * 16; *(uint4*)(d_) = g0; *(uint4*)(d_ + 4096) = g1; *(uint4*)(d_ + 8192) = g2; \
    *(uint4*)(d_ + 12288) = g3; *(uint4*)(d_ + 16384) = g4; *(uint4*)(d_ + 20480) = g5; *(uint4*)(d_ + 24576) = g6; \
    *(uint4*)(d_ + 28672) = g7; *(uint4*)(d_ + 32768) = g8; *(uint4*)(d_ + 36864) = g9; *(uint4*)(d_ + 40960) = g10; \
    *(uint4*)(d_ + 45056) = g11; *(uint4*)(d_ + 49152) = g12; *(uint4*)(d_ + 53248) = g13; } while (0)
    RG_LOAD(REC_OF(0));
    RG_STORE(smem);
    if (nch > 1) RG_LOAD(REC_OF(1));
    lds_barrier();
    for (int n = 0; n < nch; ++n) {
      if (n + 1 < nch) {
        RG_STORE(smem + ((n + 1) & 1) * R64_BYTES);
        if (n + 2 < nch) RG_LOAD(REC_OF(n + 2));
      }
      lds_barrier();
    }
#undef RG_LOAD
#undef RG_STORE
  } else {
    const int vs = wave;
    f32x16 S[4];
    if (s >= 16) {
      const float* sp = p->state + ((((size_t)(s - 16) * 2 + j) * 2 + dir) * 4 + hd) * 16384;
#pragma unroll
      for (int dt = 0; dt < 4; ++dt)
        {
#pragma unroll
          for (int q = 0; q < 16; ++q) {
            int d = 32 * dt + 8 * (q >> 2) + 4 * hh + (q & 3);
            S[dt][q] = sp[d * 128 + vs * 32 + c];
          }
          __builtin_amdgcn_sched_barrier(0);
        }
    } else {
#pragma unroll
      for (int dt = 0; dt < 4; ++dt)
#pragma unroll
        for (int q = 0; q < 16; ++q) S[dt][q] = 0.f;
    }
    lds_barrier();
    for (int n = 0; n < nch; ++n) {
      const unsigned char* rb = smem + (n & 1) * R64_BYTES;
      const int ck = ck0 + (dir ? nch - 1 - n : n);
      bf16x8 vf[4], sp8[8];
#pragma unroll
      for (int ks = 0; ks < 4; ++ks) vf[ks] = *(const bf16x8*)(rb + R64_VF + ((vs * 4 + ks) * 64 + lane) * 16);
#pragma unroll
      for (int f = 0; f < 8; ++f) sp8[f] = pack8(S[f >> 1], f & 1);
#pragma unroll
      for (int mT = 0; mT < 2; ++mT) {
        bf16x8 qf[8], pf[4];
#pragma unroll
        for (int f = 0; f < 8; ++f) qf[f] = *(const bf16x8*)(rb + R64_QF + ((mT * 8 + f) * 64 + lane) * 16);
        if (mT == 0) {
          pf[0] = *(const bf16x8*)(rb + R64_PF + (0 * 64 + lane) * 16); pf[1] = *(const bf16x8*)(rb + R64_PF + (1 * 64 + lane) * 16);
        } else {
          pf[0] = *(const bf16x8*)(rb + R64_PF + (2 * 64 + lane) * 16); pf[1] = *(const bf16x8*)(rb + R64_PF + (3 * 64 + lane) * 16);
          pf[2] = *(const bf16x8*)(rb + R64_PF + (4 * 64 + lane) * 16); pf[3] = *(const bf16x8*)(rb + R64_PF + (5 * 64 + lane) * 16);
        }
        __builtin_amdgcn_sched_barrier(0);
        f32x16 o;
#pragma unroll
        for (int q = 0; q < 16; ++q) o[q] = 0.f;
        o = mfma32(pf[0], vf[0], o);
        o = mfma32(pf[1], vf[1], o);
        if (mT == 1) { o = mfma32(pf[2], vf[2], o); o = mfma32(pf[3], vf[3], o); }
#pragma unroll
        for (int f = 0; f < 8; ++f) o = mfma32(qf[f], sp8[f], o);
        __builtin_amdgcn_sched_barrier(0);
#pragma unroll
        for (int q = 0; q < 16; ++q) {
          const int tr = 32 * mT + 8 * (q >> 2) + 4 * hh + (q & 3);
          const int row = ck * 64 + (dir ? 63 - tr : tr);
          obuf[(size_t)row * 512 + hd * 128 + vs * 32 + c] = (bf16_t)pk2(o[q], 0.f);
        }
      }
#pragma unroll
      for (int dt = 0; dt < 4; ++dt) {
        bf16x8 kf[4];
        f32x4 al[4];
#pragma unroll
        for (int ks = 0; ks < 4; ++ks) kf[ks] = *(const bf16x8*)(rb + R64_KF + ((dt * 4 + ks) * 64 + lane) * 16);
#pragma unroll
        for (int g = 0; g < 4; ++g) al[g] = *(const f32x4*)(rb + R64_AL + (32 * dt + 8 * g + 4 * hh) * 4);
#pragma unroll
        for (int g = 0; g < 4; ++g) {
          S[dt][4 * g + 0] *= al[g][0]; S[dt][4 * g + 1] *= al[g][1]; S[dt][4 * g + 2] *= al[g][2]; S[dt][4 * g + 3] *= al[g][3];
        }
#pragma unroll
        for (int ks = 0; ks < 4; ++ks) S[dt] = mfma32(kf[ks], vf[ks], S[dt]);
      }
      lds_barrier();
    }
    if (s < 16) {
      int lz = 0; asm volatile("" : "+v"(lz));
      float* op = p->out + (size_t)NTOK * DM + ((((size_t)s * 2 + j) * 2 + dir) * 4 + hd) * 16384;
#pragma unroll
      for (int dt = 0; dt < 4; ++dt)
        {
#pragma unroll
          for (int q = 0; q < 16; ++q) {
            int d = 32 * dt + 8 * (q >> 2) + 4 * hh + (q & 3);
            op[d * 128 + vs * 32 + c + lz] = S[dt][q];
          }
          __builtin_amdgcn_sched_barrier(0);
        }
    }
  }
#undef REC_OF
  __syncthreads();
}

DI void pool_job(PP p, int job, unsigned char* smem) {
  bf16_t* T = (bf16_t*)smem;
  bf16_t* Gt = T + 32 * 512;
  const int tid = threadIdx.x, cp = tid & 255, tsub = tid >> 8;
  const int g = cp >> 6, half = 1 << g;
  const int rowb = job * 16;
  const int L = (rowb < NCTX) ? 256 : 1024;
  const int seq0 = (rowb < NCTX) ? (rowb & ~255) : NCTX + ((rowb - NCTX) & ~1023);
  const int tb = rowb - seq0;
#pragma unroll
  for (int i = 0; i < 4; ++i) {
    const int e = tid + NTHR * i, r = e >> 6, c16 = e & 63, t = tb - 8 + r;
    if (t >= 0 && t < L) *(uint4*)(T + r * 512 + c16 * 8) = *(const uint4*)(p->z + (size_t)(seq0 + t) * ZN_REC + c16 * 8);
  }
#pragma unroll
  for (int i = 0; i < 2; ++i) {
    const int e = tid + NTHR * i, r = e >> 6, c16 = e & 63;
    *(uint4*)(Gt + r * 512 + c16 * 8) = *(const uint4*)(p->z + (size_t)(rowb + r) * ZN_REC + 512 + c16 * 8);
  }
  __syncthreads();
  {
    const int tl0 = tsub * 8, t0 = tb + tl0;
    int lo = max(t0 - half, 0), hi = min(t0 + half, L);
    float s0 = 0.f, s1 = 0.f;
    for (int sidx = lo; sidx < hi; ++sidx) {
      unsigned u = *(const unsigned*)(T + (sidx - tb + 8) * 512 + 2 * cp);
      s0 += __uint_as_float(u << 16); s1 += __uint_as_float(u & 0xffff0000u);
    }
#pragma unroll
    for (int i = 0; i < 8; ++i) {
      const int tl = tl0 + i, t = tb + tl, row = rowb + tl;
      const float inv = __builtin_amdgcn_rcpf((float)(hi - lo));
      const unsigned us = *(const unsigned*)(T + (tl + 8) * 512 + 2 * cp);
      const unsigned ug = *(const unsigned*)(Gt + tl * 512 + 2 * cp);
      const float y0 = (s0 * inv - __uint_as_float(us << 16)) * silu_f(__uint_as_float(ug << 16));
      const float y1 = (s1 * inv - __uint_as_float(us & 0xffff0000u)) * silu_f(__uint_as_float(ug & 0xffff0000u));
      *(unsigned*)(p->r + (size_t)row * DM + 2 * cp) = pk2(y0, y1);
      if (t + half < L) { const unsigned u = *(const unsigned*)(T + (tl + half + 8) * 512 + 2 * cp); s0 += __uint_as_float(u << 16); s1 += __uint_as_float(u & 0xffff0000u); ++hi; }
      if (t - half >= 0) { const unsigned u = *(const unsigned*)(T + (tl - half + 8) * 512 + 2 * cp); s0 -= __uint_as_float(u << 16); s1 -= __uint_as_float(u & 0xffff0000u); ++lo; }
    }
  }
  __syncthreads();
}

DI void phase_scan(PP p, int j, unsigned char* smem) {
  scan_prep64(p, j, smem);
}
DI void phase_chain(PP p, int j, unsigned char* smem) {
  const int b = blockIdx.x, G = gridDim.x;
  for (int item = b; item < 192; item += G) scan_chain_item64(p, j, item, smem);
  if (G > 64) { if (b >= 64) for (int pj = b - 64; pj < NTOK / 16; pj += G - 64) pool_job(p, pj, smem); }
  else for (int pj = b; pj < NTOK / 16; pj += G) pool_job(p, pj, smem);
}

DI void phase_combine(PP p, int j) {
  const int wave = threadIdx.x >> 6, lane = threadIdx.x & 63;
  const bf16_t* of = (const bf16_t*)p->oproj;
  const bf16_t* ob = of + (size_t)NTOK * 512;
  const float2 hn = *(const float2*)(p->rec_head_norm + j * 128 + 2 * lane);
  for (int pi = blockIdx.x * 8 + wave; pi < NTOK / 2; pi += gridDim.x * 8) {
    unsigned ua[2][4], ub[2][4], ug[2][4], res[2][4];
#pragma unroll
    for (int r = 0; r < 2; ++r)
#pragma unroll
      for (int hd = 0; hd < 4; ++hd) {
        const int row = 2 * pi + r, col = hd * 128 + 2 * lane;
        ua[r][hd] = *(const unsigned*)(of + (size_t)row * 512 + col);
        ub[r][hd] = *(const unsigned*)(ob + (size_t)row * 512 + col);
        ug[r][hd] = *(const unsigned*)(p->z + (size_t)row * ZN_REC + 3072 + col);
      }
    float o0[2][4], o1[2][4], ss[2][4];
#pragma unroll
    for (int r = 0; r < 2; ++r)
#pragma unroll
      for (int hd = 0; hd < 4; ++hd) {
        o0[r][hd] = __uint_as_float(ua[r][hd] << 16) + __uint_as_float(ub[r][hd] << 16);
        o1[r][hd] = __uint_as_float(ua[r][hd] & 0xffff0000u) + __uint_as_float(ub[r][hd] & 0xffff0000u);
        ss[r][hd] = o0[r][hd] * o0[r][hd] + o1[r][hd] * o1[r][hd];
      }
#pragma unroll
    for (int r = 0; r < 2; ++r)
#pragma unroll
      for (int hd = 0; hd < 4; ++hd) ss[r][hd] = wave_sum(ss[r][hd]);
#pragma unroll
    for (int r = 0; r < 2; ++r)
#pragma unroll
      for (int hd = 0; hd < 4; ++hd) {
        const float rstd = rsqrtf(ss[r][hd] * (1.f / 128.f) + EPS);
        const float y0 = o0[r][hd] * rstd * hn.x * silu_f(__uint_as_float(ug[r][hd] << 16));
        const float y1 = o1[r][hd] * rstd * hn.y * silu_f(__uint_as_float(ug[r][hd] & 0xffff0000u));
        res[r][hd] = pk2(y0, y1);
      }
#pragma unroll
    for (int r = 0; r < 2; ++r)
#pragma unroll
      for (int hd = 0; hd < 4; ++hd) *(unsigned*)(p->r + (size_t)(2 * pi + r) * DM + 512 + hd * 128 + 2 * lane) = res[r][hd];
  }
}

DI void vt_job(PP p, int ja, int jb, unsigned char* smem) {
  bf16_t* T = (bf16_t*)smem;
  const int tid = threadIdx.x;
  const int row = tid >> 3, cseg = (tid & 7) * 32;
  bf16_t* dst; int dstL, pos0;
  if (jb < 64) {
    const int seq = jb >> 2; pos0 = (jb & 3) * 64;
    const bf16_t* src = p->z + (size_t)(seq * 256 + pos0 + row) * ZN_ATT + 1280 + cseg;
#pragma unroll
    for (int i = 0; i < 4; ++i) {
      bf16x8 v = *(const bf16x8*)(src + i * 8);
#pragma unroll
      for (int e = 0; e < 8; ++e) T[row * 258 + cseg + i * 8 + e] = (bf16_t)v[e];
    }
    dst = p->Vc + (size_t)seq * 2 * 128 * 256; dstL = 256;
  } else {
    const int jl = jb - 64, b = jl / 24, tile = jl % 24; pos0 = tile * 64;
    if (tile < 8) {
      const float* src = p->cache_v + ((size_t)(b * 2 + ja) * 512 + pos0 + row) * 256 + cseg;
#pragma unroll
      for (int i = 0; i < 8; ++i) {
        f32x4 v = *(const f32x4*)(src + i * 4);
#pragma unroll
        for (int e = 0; e < 4; ++e) T[row * 258 + cseg + i * 4 + e] = f2bf(v[e]);
      }
    } else {
      const bf16_t* src = p->z + (size_t)(NCTX + b * 1024 + pos0 - 512 + row) * ZN_ATT + 1280 + cseg;
#pragma unroll
      for (int i = 0; i < 4; ++i) {
        bf16x8 v = *(const bf16x8*)(src + i * 8);
#pragma unroll
        for (int e = 0; e < 8; ++e) T[row * 258 + cseg + i * 8 + e] = (bf16_t)v[e];
      }
    }
    dst = p->Vl + (size_t)b * 2 * 128 * 1536; dstL = 1536;
  }
  __syncthreads();
#pragma unroll
  for (int k = 0; k < 4; ++k) {
    int piece = tid + 512 * k, orow = piece >> 3, seg = piece & 7;
    uint4 o;
    o.x = (unsigned)T[(seg * 8 + 0) * 258 + orow] | ((unsigned)T[(seg * 8 + 1) * 258 + orow] << 16);
    o.y = (unsigned)T[(seg * 8 + 2) * 258 + orow] | ((unsigned)T[(seg * 8 + 3) * 258 + orow] << 16);
    o.z = (unsigned)T[(seg * 8 + 4) * 258 + orow] | ((unsigned)T[(seg * 8 + 5) * 258 + orow] << 16);
    o.w = (unsigned)T[(seg * 8 + 6) * 258 + orow] | ((unsigned)T[(seg * 8 + 7) * 258 + orow] << 16);
    *(uint4*)(dst + (size_t)orow * dstL + pos0 + seg * 8) = o;
  }
  __syncthreads();
}

DI void phase_kvprep(PP p, int ja, unsigned char* smem) {
  const int wave = threadIdx.x >> 6, lane = threadIdx.x & 63;
  float* outk = p->out + (size_t)NTOK * DM + 4194304;
  float* outv = outk + 2097152;
  const float2 wq = *(const float2*)(p->att_q_norm + ja * 128 + 2 * lane), wk = *(const float2*)(p->att_k_norm + ja * 128 + 2 * lane);
  const int stride = gridDim.x * 8;
  {
    int row = blockIdx.x * 8 + wave;
    unsigned u[10], un[10]; uint2 uv, uvn; float cs = 1.f, sn = 0.f, csn = 1.f, snn = 0.f;
#define KV_LOAD(R, U, UV, CS, SN) do { const bf16_t* zr_ = p->z + (size_t)(R) * ZN_ATT; \
      _Pragma("unroll") for (int hq = 0; hq < 10; ++hq) U[hq] = *(const unsigned*)(zr_ + hq * 128 + 2 * lane); \
      UV = *(const uint2*)(zr_ + 1280 + 4 * lane); \
      if ((R) >= NCTX) { const int t_ = ((R) - NCTX) & 1023; CS = p->ropec[t_ * 64 + lane]; SN = p->ropes[t_ * 64 + lane]; } else { CS = 1.f; SN = 0.f; } } while (0)
    if (row < NTOK) KV_LOAD(row, u, uv, cs, sn);
    while (row < NTOK) {
      const int nrow = row + stride;
      if (nrow < NTOK) KV_LOAD(nrow, un, uvn, csn, snn);
      const bool lat = row >= NCTX;
      const int b = lat ? ((row - NCTX) >> 10) : (row >> 8);
      const int t = lat ? ((row - NCTX) & 1023) : (row & 255);
      float r1[10], r2[10];
#pragma unroll
      for (int hq = 0; hq < 10; ++hq) {
        float x1 = __uint_as_float(u[hq] << 16), x2 = __uint_as_float(u[hq] & 0xffff0000u);
        float ss = wave_sum(x1 * x1 + x2 * x2);
        float rstd = rsqrtf(ss * (1.f / 128.f) + EPS);
        float y1 = x1 * rstd * ((hq < 8) ? wq.x : wk.x), y2 = x2 * rstd * ((hq < 8) ? wq.y : wk.y);
        r1[hq] = y1 * cs - y2 * sn; r2[hq] = y1 * sn + y2 * cs;
      }
#pragma unroll
      for (int hq = 0; hq < 8; ++hq) *(unsigned*)(p->h + (size_t)row * DM + hq * 128 + 2 * lane) = pk2(r1[hq], r2[hq]);
#pragma unroll
      for (int g = 0; g < 2; ++g) {
        if (!lat) {
          *(float2*)(outk + ((size_t)(b * 2 + ja) * 256 + t) * 256 + g * 128 + 2 * lane) = make_float2(r1[8 + g], r2[8 + g]);
          *(unsigned*)(p->Kc + ((size_t)b * 256 + t) * 256 + g * 128 + 2 * lane) = pk2(r1[8 + g], r2[8 + g]);
        } else {
          *(unsigned*)(p->Kl + ((size_t)b * 1536 + 512 + t) * 256 + g * 128 + 2 * lane) = pk2(r1[8 + g], r2[8 + g]);
        }
      }
      if (!lat) {
        f32x4 v = (f32x4){__uint_as_float(uv.x << 16), __uint_as_float(uv.x & 0xffff0000u), __uint_as_float(uv.y << 16), __uint_as_float(uv.y & 0xffff0000u)};
        *(f32x4*)(outv + ((size_t)(b * 2 + ja) * 256 + t) * 256 + 4 * lane) = v;
        *(uint2*)(p->Vc + ((size_t)b * 256 + t) * 256 + 4 * lane) = uv;
      } else {
        *(uint2*)(p->Vl + ((size_t)b * 1536 + 512 + t) * 256 + 4 * lane) = uv;
      }
#pragma unroll
      for (int hq = 0; hq < 10; ++hq) u[hq] = un[hq];
      uv = uvn; cs = csn; sn = snn; row = nrow;
    }
#undef KV_LOAD
  }
  for (int cr = blockIdx.x * 8 + wave; cr < 4096; cr += 2 * stride) {
    const int cr2 = cr + stride;
    const int b = cr >> 9, pp = cr & 511, b2 = (cr2 & 4095) >> 9, pp2 = cr2 & 511;
    const bool has2 = cr2 < 4096;
    f32x4 v = *(const f32x4*)(p->cache_k + ((size_t)(b * 2 + ja) * 512 + pp) * 256 + 4 * lane);
    f32x4 w = *(const f32x4*)(p->cache_v + ((size_t)(b * 2 + ja) * 512 + pp) * 256 + 4 * lane);
    f32x4 v2 = v, w2 = w;
    if (has2) { v2 = *(const f32x4*)(p->cache_k + ((size_t)(b2 * 2 + ja) * 512 + pp2) * 256 + 4 * lane);
                w2 = *(const f32x4*)(p->cache_v + ((size_t)(b2 * 2 + ja) * 512 + pp2) * 256 + 4 * lane); }
    uint2 o; o.x = pk2(v[0], v[1]); o.y = pk2(v[2], v[3]);
    *(uint2*)(p->Kl + ((size_t)b * 1536 + pp) * 256 + 4 * lane) = o;
    o.x = pk2(w[0], w[1]); o.y = pk2(w[2], w[3]);
    *(uint2*)(p->Vl + ((size_t)b * 1536 + pp) * 256 + 4 * lane) = o;
    if (has2) {
      o.x = pk2(v2[0], v2[1]); o.y = pk2(v2[2], v2[3]);
      *(uint2*)(p->Kl + ((size_t)b2 * 1536 + pp2) * 256 + 4 * lane) = o;
      o.x = pk2(w2[0], w2[1]); o.y = pk2(w2[2], w2[3]);
      *(uint2*)(p->Vl + ((size_t)b2 * 1536 + pp2) * 256 + 4 * lane) = o;
    }
  }
}

namespace att {
using bf16 = unsigned short;
constexpr int   D = 128, NW = 8, QBLK = 32, KVBLK = 64;
constexpr float SCALE = 0.088388347648318440f;
constexpr float THR = 8.f;
constexpr int SDEPTH = 2;
constexpr int LDQ = 1024, LDK = 256, LDO = 1024, LDG = 2560;
constexpr size_t SHM_V = KVBLK * D * 2, SHM_K = KVBLK * D * 2, SHM_ATTN = 2 * SHM_V + 2 * SHM_K + NW * 64 * 4;
using s16x4  = __attribute__((ext_vector_type(4))) short;
using f32x8  = __attribute__((ext_vector_type(8))) float;
using u32x4  = __attribute__((ext_vector_type(4))) unsigned;
#define KSWZ(row, colB) ((row) * 256 + ((colB) ^ (((row) & 7) << 4)))
#define SBAR() __builtin_amdgcn_sched_barrier(0)
__device__ __forceinline__ int crow(int r, int hi) { return (r & 3) + 8 * (r >> 2) + 4 * hi; }
__device__ __forceinline__ unsigned cvtpk(float lo, float hi) {
  unsigned r; asm volatile("v_cvt_pk_bf16_f32 %0, %1, %2" : "=v"(r) : "v"(lo), "v"(hi)); return r;
}
template <typename TIn> struct Stage;
template <> struct Stage<bf16>  { using T = bf16x8;
  __device__ static __forceinline__ T ld8(const bf16* p) { return *reinterpret_cast<const bf16x8*>(p); }
  __device__ static __forceinline__ bf16x8 tobf(T x) { return x; } };
__device__ __forceinline__ void partialSM(f32x16& p0, f32x16& p1, float& m_reg, float& mn, float& alpha) {
  constexpr float C = SCALE * 1.4426950408889634f;
  float pmax = p0[0]; for (int r = 1; r < 16; ++r) pmax = fmaxf(pmax, p0[r]); for (int r = 0; r < 16; ++r) pmax = fmaxf(pmax, p1[r]);
  { auto rr = __builtin_amdgcn_permlane32_swap(__float_as_uint(pmax), __float_as_uint(pmax), false, false);
    pmax = fmaxf(__uint_as_float(rr[0]), __uint_as_float(rr[1])); }
  if (__builtin_expect(__all(pmax - m_reg <= THR / SCALE), 1)) { mn = m_reg; alpha = 1.f; }
  else { mn = fmaxf(m_reg, pmax); alpha = __builtin_amdgcn_exp2f((m_reg - mn) * C); m_reg = mn; }
  float mnC = -mn * C;
  for (int r = 0; r < 16; ++r) p0[r] = fmaf(p0[r], C, mnC); for (int r = 0; r < 16; ++r) p1[r] = fmaf(p1[r], C, mnC);
  for (int r = 0; r < 16; ++r) p0[r] = __builtin_amdgcn_exp2f(p0[r]);
}
__device__ __forceinline__ void finishSM(f32x16& p0, f32x16& p1, float alpha, float& l_reg, bf16x8& pa0, bf16x8& pa1, bf16x8& pa2, bf16x8& pa3) {
  for (int r = 0; r < 16; ++r) p1[r] = __builtin_amdgcn_exp2f(p1[r]);
  float ps = 0; for (int r = 0; r < 16; ++r) ps += p0[r]; for (int r = 0; r < 16; ++r) ps += p1[r];
  { auto rr = __builtin_amdgcn_permlane32_swap(__float_as_uint(ps), __float_as_uint(ps), false, false);
    ps = __uint_as_float(rr[0]) + __uint_as_float(rr[1]); }
  l_reg = l_reg * alpha + ps;
#define PK4(P, BASE, OUT) do { unsigned a0 = cvtpk(P[BASE + 0], P[BASE + 1]), a1 = cvtpk(P[BASE + 2], P[BASE + 3]);   \
    unsigned b0 = cvtpk(P[BASE + 4], P[BASE + 5]), b1 = cvtpk(P[BASE + 6], P[BASE + 7]);                              \
    auto r0 = __builtin_amdgcn_permlane32_swap(a0, b0, false, false); auto r1 = __builtin_amdgcn_permlane32_swap(a1, b1, false, false); \
    u32x4 w = {r0[0], r1[0], r0[1], r1[1]}; OUT = *reinterpret_cast<bf16x8*>(&w); } while (0)
  PK4(p0, 0, pa0); PK4(p0, 8, pa1); PK4(p1, 0, pa2); PK4(p1, 8, pa3);
#undef PK4
}
__device__ __forceinline__ void qkt(f32x16& p0, f32x16& p1, const bf16* Ks, const bf16x8* qr, int r32, int hi) {
  p0 = f32x16{}; p1 = f32x16{};
  for (int d0 = 0; d0 < 8; ++d0) { int cb = (d0 * 16 + hi * 8) * 2;
    bf16x8 b0 = *reinterpret_cast<const bf16x8*>((const char*)Ks + KSWZ(r32, cb));
    bf16x8 b1 = *reinterpret_cast<const bf16x8*>((const char*)Ks + KSWZ(32 + r32, cb));
    p0 = __builtin_amdgcn_mfma_f32_32x32x16_bf16(b0, qr[d0], p0, 0, 0, 0);
    p1 = __builtin_amdgcn_mfma_f32_32x32x16_bf16(b1, qr[d0], p1, 0, 0, 0); }
}
__device__ __forceinline__ int v_st(int k, int c) { const int kk = (k & ~0xC) | ((k & 4) << 1) | ((k & 8) >> 1); return ((kk >> 3) * 4 + (c >> 5)) * 512 + ((kk & 7) * 32 + (c & 31)) * 2; }
__device__ __forceinline__ int v_rd_base(int lane) { return ((lane & 3) << 3) | (((lane >> 2) & 3) << 6) | (((lane >> 4) & 1) << 5) | (((lane >> 5) & 1) << 8); }
constexpr int v_rd_off(int d0, int ks, int half) { return d0 * 512 + ks * 4096 + half * 2048; }
template <int OFF> __device__ __forceinline__ s16x4 tr_read(int vb) {
  s16x4 r; asm volatile("ds_read_b64_tr_b16 %0, %1 offset:%2" : "=&v"(r) : "v"(vb), "i"(OFF) : "memory"); return r;
}
template <int D0> __device__ __forceinline__ void pv_one(f32x16& od, int vb, bf16x8 pa0, bf16x8 pa1, bf16x8 pa2, bf16x8 pa3) {
  const s16x4 l0 = tr_read<v_rd_off(D0, 0, 0)>(vb), h0 = tr_read<v_rd_off(D0, 0, 1)>(vb), l1 = tr_read<v_rd_off(D0, 1, 0)>(vb), h1 = tr_read<v_rd_off(D0, 1, 1)>(vb);
  const s16x4 l2 = tr_read<v_rd_off(D0, 2, 0)>(vb), h2 = tr_read<v_rd_off(D0, 2, 1)>(vb), l3 = tr_read<v_rd_off(D0, 3, 0)>(vb), h3 = tr_read<v_rd_off(D0, 3, 1)>(vb);
  asm volatile("s_waitcnt lgkmcnt(0)" ::: "memory"); SBAR();
#define PK(L, H) (bf16x8){L[0], L[1], L[2], L[3], H[0], H[1], H[2], H[3]}
  od = __builtin_amdgcn_mfma_f32_32x32x16_bf16(pa0, PK(l0, h0), od, 0, 0, 0);
  od = __builtin_amdgcn_mfma_f32_32x32x16_bf16(pa1, PK(l1, h1), od, 0, 0, 0);
  od = __builtin_amdgcn_mfma_f32_32x32x16_bf16(pa2, PK(l2, h2), od, 0, 0, 0);
  od = __builtin_amdgcn_mfma_f32_32x32x16_bf16(pa3, PK(l3, h3), od, 0, 0, 0);
#undef PK
}
__device__ __forceinline__ void pv_d0(f32x16* o, int vb, bf16x8 pa0, bf16x8 pa1, bf16x8 pa2, bf16x8 pa3) {
  pv_one<0>(o[0], vb, pa0, pa1, pa2, pa3); pv_one<1>(o[1], vb, pa0, pa1, pa2, pa3); pv_one<2>(o[2], vb, pa0, pa1, pa2, pa3); pv_one<3>(o[3], vb, pa0, pa1, pa2, pa3);
}

template <typename TQ>
__device__ __forceinline__ void attn_dense_body(const TQ* __restrict__ Qb, const bf16* __restrict__ Kh, const bf16* __restrict__ Vh,
                                                const bf16* __restrict__ Gb, bf16* __restrict__ Ob, int seq, char* lds) {
  using St = Stage<bf16>; using SQ = Stage<TQ>;
  const int tid = threadIdx.x, wid = tid >> 6, lane = tid & 63, r32 = lane & 31, hi = lane >> 5;
  bf16* V_lds = (bf16*)lds; bf16* K_lds = (bf16*)(lds + 2 * SHM_V);
  float* ws = (float*)(lds + 2 * SHM_V + 2 * SHM_K) + wid * 64; float* li_l = ws; float* al_l = ws + 32;
  float m_reg = -1e30f, l_reg = 0; f32x16 o[4] = {}; bf16x8 qr[8];
  const TQ* Qw = Qb + (long)(wid * QBLK + r32) * LDQ + hi * 8;
#pragma unroll
  for (int d0 = 0; d0 < 8; ++d0) qr[d0] = SQ::tobf(SQ::ld8(Qw + d0 * 16));
  const int sr = tid >> 4, sc = (tid & 15) * 8, vst0 = v_st(sr, sc), vst1 = v_st(32 + sr, sc);
  const int vb0 = (int)(uintptr_t)V_lds + v_rd_base(lane);
  struct { typename St::T vs0, vs1, ks0, ks1; } sr_[SDEPTH];
#define SLOAD(i, k0) do { sr_[i].vs0 = St::ld8(&Vh[(long)((k0) + sr) * LDK + sc]); sr_[i].vs1 = St::ld8(&Vh[(long)((k0) + 32 + sr) * LDK + sc]); \
    sr_[i].ks0 = St::ld8(&Kh[(long)((k0) + sr) * LDK + sc]); sr_[i].ks1 = St::ld8(&Kh[(long)((k0) + 32 + sr) * LDK + sc]); } while (0)
#define SWRITE(b, i) do { *(bf16x8*)((char*)V_lds + (b) * SHM_V + vst0) = St::tobf(sr_[i].vs0);          \
    *(bf16x8*)((char*)V_lds + (b) * SHM_V + vst1) = St::tobf(sr_[i].vs1); int kc = sc * 2;               \
    *(bf16x8*)((char*)K_lds + (b) * SHM_K + KSWZ(sr, kc)) = St::tobf(sr_[i].ks0);                       \
    *(bf16x8*)((char*)K_lds + (b) * SHM_K + KSWZ(32 + sr, kc)) = St::tobf(sr_[i].ks1); } while (0)
#define SWAIT() do { if constexpr (SDEPTH == 2) asm volatile("s_waitcnt vmcnt(4)" ::: "memory"); else asm volatile("s_waitcnt vmcnt(0)" ::: "memory"); } while (0)
#define RESC(a) do { if (__any((a) < 1.f)) { if (hi == 0) al_l[r32] = (a); asm volatile("s_waitcnt lgkmcnt(0)" ::: "memory"); \
    for (int d = 0; d < 4; ++d) for (int r = 0; r < 16; ++r) o[d][r] *= al_l[crow(r, hi)]; } } while (0)
  f32x16 pA0, pA1, pB0, pB1; float mnA, mnB, alA, alB; bf16x8 pa0, pa1, pa2, pa3; const int NT = seq / KVBLK;
  constexpr int SE = 0, SO = SDEPTH - 1;
  SLOAD(SE, 0); asm volatile("s_waitcnt vmcnt(0)" ::: "memory"); SWRITE(0, SE); __syncthreads();
  qkt(pA0, pA1, K_lds, qr, r32, hi); partialSM(pA0, pA1, m_reg, mnA, alA);
  SLOAD(SO, KVBLK); if constexpr (SDEPTH == 2) { if (2 < NT) SLOAD(SE, 2 * KVBLK); }
  SWAIT(); SWRITE(1, SO); __syncthreads();
  for (int j = 1; j + 1 < NT; j += 2) {
    SBAR(); qkt(pB0, pB1, (bf16*)((char*)K_lds + SHM_K), qr, r32, hi);
    finishSM(pA0, pA1, alA, l_reg, pa0, pa1, pa2, pa3); SBAR();
    SLOAD(SO, (j + SDEPTH) * KVBLK); SBAR();
    pv_d0(o, vb0, pa0, pa1, pa2, pa3); partialSM(pB0, pB1, m_reg, mnB, alB);
    __syncthreads(); SWAIT(); SWRITE(0, SE);
    RESC(alB); __syncthreads();
    SBAR(); qkt(pA0, pA1, K_lds, qr, r32, hi);
    finishSM(pB0, pB1, alB, l_reg, pa0, pa1, pa2, pa3); SBAR();
    if (SDEPTH == 1 || j + 3 < NT) SLOAD(SE, (j + 1 + SDEPTH) * KVBLK); SBAR();
    pv_d0(o, vb0 + (int)SHM_V, pa0, pa1, pa2, pa3); partialSM(pA0, pA1, m_reg, mnA, alA);
    __syncthreads(); SWAIT(); SWRITE(1, SO);
    RESC(alA); __syncthreads();
  }
  SBAR(); qkt(pB0, pB1, (bf16*)((char*)K_lds + SHM_K), qr, r32, hi);
  finishSM(pA0, pA1, alA, l_reg, pa0, pa1, pa2, pa3); SBAR();
  pv_d0(o, vb0, pa0, pa1, pa2, pa3); partialSM(pB0, pB1, m_reg, mnB, alB);
  __syncthreads(); RESC(alB);
  finishSM(pB0, pB1, alB, l_reg, pa0, pa1, pa2, pa3); SBAR();
  pv_d0(o, vb0 + (int)SHM_V, pa0, pa1, pa2, pa3);
  if (hi == 0) li_l[r32] = l_reg; asm volatile("s_waitcnt lgkmcnt(0)" ::: "memory");
  float rli[16];
#pragma unroll
  for (int r = 0; r < 16; ++r) rli[r] = __builtin_amdgcn_rcpf(li_l[crow(r, hi)]);
  int lofs = 4 * hi; asm volatile("" : "+v"(lofs));
  const bf16* Gw = Gb + (long)(wid * QBLK + lofs) * LDG + r32; bf16* Ow = Ob + (long)(wid * QBLK + lofs) * LDO + r32;
#pragma unroll
  for (int d0 = 0; d0 < 4; ++d0) {
    unsigned short gv[16];
#pragma unroll
    for (int r = 0; r < 16; ++r) gv[r] = Gw[(long)((r & 3) + 8 * (r >> 2)) * LDG + d0 * 32];
#pragma unroll
    for (int r = 0; r < 16; ++r) {
      const float g = __uint_as_float(((unsigned)gv[r]) << 16);
      const float val = o[d0][r] * rli[r] * (g * __builtin_amdgcn_rcpf(1.f + __expf(-g)));
      Ow[(long)((r & 3) + 8 * (r >> 2)) * LDO + d0 * 32] = (bf16)(cvtpk(val, 0.f) & 0xffffu);
    }
  }
#undef SLOAD
#undef SWRITE
#undef SWAIT
#undef RESC
}

#undef KSWZ
#undef SBAR
}

DI void att_item(PP p, int qrow0, int head, const bf16_t* Kb, const bf16_t* Vb, int Lk, unsigned char* smem) {
  __syncthreads();
  att::attn_dense_body<att::bf16>(p->h + (size_t)qrow0 * DM + head * 128, Kb, Vb, p->z + (size_t)qrow0 * ZN_ATT + 1536 + head * 128,
                                  p->r + (size_t)qrow0 * DM + head * 128, Lk, (char*)smem);
}

DI void phase_att(PP p, unsigned char* smem) {
  for (int item = blockIdx.x; item < 384; item += gridDim.x) {
    int qrow0, head, Lk; const bf16_t* Kb; const bf16_t* Vb;
    if (item < 256) {
      const int xcd = item & 7, slot = item >> 3;
      const int bg = xcd * 2 + (slot >> 4), within = slot & 15;
      const int b = bg >> 1, g = bg & 1, qt = within & 3;
      head = g * 4 + (within >> 2); qrow0 = NCTX + b * 1024 + qt * 256; Lk = 1536;
      Kb = p->Kl + (size_t)b * 1536 * 256 + g * 128; Vb = p->Vl + (size_t)b * 1536 * 256 + g * 128;
    } else {
      const int id2 = item - 256, xcd = id2 & 7, slot = id2 >> 3;
      const int grp = xcd * 4 + (slot >> 2), seq = grp >> 1, g = grp & 1;
      head = g * 4 + (slot & 3); qrow0 = seq * 256; Lk = 256;
      Kb = p->Kc + (size_t)seq * 256 * 256 + g * 128; Vb = p->Vc + (size_t)seq * 256 * 256 + g * 128;
    }
    att_item(p, qrow0, head, Kb, Vb, Lk, smem);
  }
}

#define XB_TMO      128
#define XB_XCNT(j)  (256  + 64 * (j))
#define XB_XSUB(j)  (1280 + 64 * (j))
#define XB_XGEN(j)  (2304 + 64 * (j))
#define XB_TOP      3328
#define XB_TOPGEN   3392
#define XCD_BAR_WORDS 3456
#define XB_SPIN_CAP (1u << 18)
DI unsigned xb_ld(unsigned* p) { return __hip_atomic_load(p, __ATOMIC_RELAXED, __HIP_MEMORY_SCOPE_AGENT); }
DI unsigned xb_add(unsigned* p, unsigned v) { return __hip_atomic_fetch_add(p, v, __ATOMIC_RELAXED, __HIP_MEMORY_SCOPE_AGENT); }
DI unsigned xb_xcc_id() { return (unsigned)__builtin_amdgcn_s_getreg((3 << 11) | 20) & 0xFu; }
#define XB_SPIN(cond, bar) do { unsigned _sp = 0; while (cond) { __builtin_amdgcn_s_sleep(1); \
    if ((++_sp & 255u) == 0u) { if (xb_ld(&(bar)[XB_TMO])) break; if (_sp > XB_SPIN_CAP) { atomicAdd(&(bar)[XB_TMO], 1u); break; } } } } while (0)
DI void xcd_barrier_complete(unsigned* bar, unsigned x, unsigned& nloc, unsigned& nx) {
  const unsigned G = gridDim.x;
  unsigned sum, cnt, mine, sp = 0u;
  for (;;) {
    sum = 0u; cnt = 0u; mine = 0u;
#pragma unroll
    for (unsigned j = 0; j < 16; ++j) { const unsigned c = xb_ld(&bar[XB_XCNT(j)]); sum += c; cnt += (c > 0u) ? 1u : 0u; mine = (j == x) ? c : mine; }
    if (sum == G) break;
    __builtin_amdgcn_s_sleep(1);
    if ((++sp & 255u) == 0u) { if (xb_ld(&bar[XB_TMO])) break; if (sp > XB_SPIN_CAP) { atomicAdd(&bar[XB_TMO], 1u); break; } }
  }
  nloc = mine > 0u ? mine : 1u; nx = cnt > 0u ? cnt : 1u;
}
DI void xcd_barrier(unsigned* bar, volatile LAS unsigned* st) {
  asm volatile("s_waitcnt vmcnt(0)" ::: "memory");
  __syncthreads();
  if (threadIdx.x == 0) {
    const unsigned x = xb_xcc_id();
    __builtin_amdgcn_s_waitcnt(0);
    unsigned nloc = st[0], nx = st[1];
    if (nloc == 0u) { xcd_barrier_complete(bar, x, nloc, nx); st[0] = nloc; st[1] = nx; }
    const unsigned k = st[2];
    const unsigned old = xb_add(&bar[XB_XSUB(x)], 1u);
    const unsigned gen = old / nloc;
    if (old + 1u == (gen + 1u) * nloc) {
      __builtin_amdgcn_fence(__ATOMIC_RELEASE, "agent");
      asm volatile("s_waitcnt vmcnt(0)" ::: "memory");
      const unsigned og = xb_add(&bar[XB_TOP], 1u);
      const unsigned tg = og / nx;
      __builtin_amdgcn_fence(__ATOMIC_ACQUIRE, "agent");
      if (og + 1u == (tg + 1u) * nx) xb_add(&bar[XB_TOPGEN], 1u);
      else XB_SPIN(xb_ld(&bar[XB_TOPGEN]) == k, bar);
      asm volatile("s_waitcnt vmcnt(0)" ::: "memory");
    } else {
      __builtin_amdgcn_fence(__ATOMIC_ACQUIRE, "agent");
      XB_SPIN(xb_ld(&bar[XB_TOPGEN]) == k, bar);
      asm volatile("s_waitcnt vmcnt(0)" ::: "memory");
    }
    st[2] = k + 1u;
  }
  __syncthreads();
}

__global__ void __launch_bounds__(NTHR, 2) mega(Params p_arg) {
  extern __shared__ __attribute__((aligned(16))) unsigned char smem[];
  __shared__ uint4 xb_words;
  PP p0 = (PP)__builtin_amdgcn_kernarg_segment_ptr();
  const int ph_lo = p0->ph_lo, ph_hi = p0->ph_hi, coop = p0->coop;
  if (threadIdx.x == 0) xb_words = make_uint4(0u, 0u, 0u, 0u);
  __syncthreads();
  if (coop && threadIdx.x == 0) (void)xb_add(&p0->bar[XB_XCNT(xb_xcc_id())], 1u);
  if (p0->pad == 0x7fffffff) cg::this_grid().sync();
#define PH(k, rep, ...) { if (ph_lo <= (k) && (k) < ph_hi) { for (int rep_ = 0; rep_ < (rep); ++rep_) { PP p = (PP)__builtin_amdgcn_kernarg_segment_ptr(); asm volatile("" : "+s"(p)); __VA_ARGS__; } \
    if ((k) + 1 < ph_hi && coop) xcd_barrier(p0->bar, (volatile LAS unsigned*)&xb_words); } }
  PH(0, REP_PREP, prep_jobs(p, smem, 0, blockIdx.x, gridDim.x))
  if (coop) for (int e = 0; e < EXTRA_SYNC; ++e) xcd_barrier(p0->bar, (volatile LAS unsigned*)&xb_words);
  PH(1, 1, phase_row(p, -1))
  PH(2, REP_GEMM, EpiBf16 E{p->z, ZN_REC}; phase_gemm(p->h, p->WrecT, ZN_REC, E, smem))
  PH(3, REP_SCAN, phase_scan(p, 0, smem))
  PH(4, REP_CHAIN, phase_chain(p, 0, smem))
  PH(5, REP_COMB, phase_combine(p, 0))
  PH(6, REP_GEMM, EpiBf16 E{(bf16_t*)p->oproj, 1024}; phase_gemm(p->r, p->WrecoT, 1024, E, smem); if (gridDim.x > 192) { if (blockIdx.x >= 192) prep_jobs(p, smem, 1, blockIdx.x - 192, gridDim.x - 192); } else prep_jobs(p, smem, 1, blockIdx.x, gridDim.x))
  PH(7, 1, phase_row(p, 0))
  PH(8, REP_GEMM, EpiBf16 E{p->z, ZN_ATT}; phase_gemm(p->h, p->WattT, ZN_ATT, E, smem))
  PH(9, 1, phase_kvprep(p, 0, smem))
  PH(10, REP_ATT, phase_att(p, smem))
  PH(11, REP_GEMM, EpiBf16 E{(bf16_t*)p->oproj, 1024}; phase_gemm(p->r, p->WattoT, 1024, E, smem); if (gridDim.x > 192) { if (blockIdx.x >= 192) prep_jobs(p, smem, 2, blockIdx.x - 192, gridDim.x - 192); } else prep_jobs(p, smem, 2, blockIdx.x, gridDim.x))
  PH(12, 1, phase_row(p, 1))
  PH(13, REP_GEMM, EpiBf16 E{p->z, ZN_REC}; phase_gemm(p->h, p->WrecT + (size_t)ZN_REC * 1024, ZN_REC, E, smem))
  PH(14, REP_SCAN, phase_scan(p, 1, smem))
  PH(15, REP_CHAIN, phase_chain(p, 1, smem))
  PH(16, REP_COMB, phase_combine(p, 1))
  PH(17, REP_GEMM, EpiBf16 E{(bf16_t*)p->oproj, 1024}; phase_gemm(p->r, p->WrecoT + (size_t)1024 * 1024, 1024, E, smem); if (gridDim.x > 192) { if (blockIdx.x >= 192) prep_jobs(p, smem, 3, blockIdx.x - 192, gridDim.x - 192); } else prep_jobs(p, smem, 3, blockIdx.x, gridDim.x))
  PH(18, 1, phase_row(p, 2))
  PH(19, REP_GEMM, EpiBf16 E{p->z, ZN_ATT}; phase_gemm(p->h, p->WattT + (size_t)ZN_ATT * 1024, ZN_ATT, E, smem))
  PH(20, 1, phase_kvprep(p, 1, smem))
  PH(21, REP_ATT, phase_att(p, smem))
  PH(22, REP_GEMM, EpiBf16 E{(bf16_t*)p->oproj, 1024}; phase_gemm(p->r, p->WattoT + (size_t)1024 * 1024, 1024, E, smem))
  PH(23, 1, phase_row(p, 3))
}

extern "C" void kernel_launch(void* const* d_in, const int* in_sizes, int n_in, void* d_out, int out_size, void* d_ws, size_t ws_size, hipStream_t stream) {
  static int grid = 0;
  if (grid == 0) {
    int dev = 0, cus = 0, per_cu = 0;
    hipGetDevice(&dev);
    hipDeviceGetAttribute(&cus, hipDeviceAttributeMultiprocessorCount, dev);
    hipFuncSetAttribute((const void*)mega, hipFuncAttributeMaxDynamicSharedMemorySize, LDS_BYTES);
    hipOccupancyMaxActiveBlocksPerMultiprocessor(&per_cu, (const void*)mega, NTHR, LDS_BYTES);
    if (per_cu < 1) per_cu = 1;
    grid = cus * 1;
    if (grid <= 0) grid = 256;
  }
  Params hp{};
  const float* const* in = (const float* const*)d_in;
  hp.x_prompt = in[0]; hp.x_sample = in[1]; hp.c = in[2]; hp.state = in[3]; hp.cache_k = in[4]; hp.cache_v = in[5]; hp.c_ctx = in[6];
  hp.ada_w = in[7]; hp.ada_b = in[8]; hp.norm_pre = in[9]; hp.norm_post = in[10]; hp.rec_w_in = in[11]; hp.rec_lb = in[12];
  hp.rec_head_norm = in[13]; hp.pool_w = in[14]; hp.pool_scale = in[15]; hp.rec_w_out = in[16]; hp.att_w_in = in[17];
  hp.att_q_norm = in[18]; hp.att_k_norm = in[19]; hp.att_w_out = in[20];
  hp.out = (float*)d_out;
  unsigned char* w = (unsigned char*)d_ws;
  size_t off = 0;
  auto take = [&](size_t bytes) { unsigned char* q = w + off; off += (bytes + 255) & ~(size_t)255; return q; };
  hp.WrecT = (bf16_t*)take((size_t)2 * ZN_REC * 1024 * 2);
  hp.WrecoT = (bf16_t*)take((size_t)2 * 1024 * 1024 * 2);
  hp.WattT = (bf16_t*)take((size_t)2 * ZN_ATT * 1024 * 2);
  hp.WattoT = (bf16_t*)take((size_t)2 * 1024 * 1024 * 2);
  hp.mod = (float*)take((size_t)4 * 9 * 3072 * 4);
  hp.lb = (float*)take(2048 * 4);
  hp.ropec = (float*)take(1024 * 64 * 4);
  hp.ropes = (float*)take(1024 * 64 * 4);
  hp.z = (bf16_t*)take((size_t)NTOK * ZN_REC * 2);
  hp.r = (bf16_t*)take((size_t)NTOK * DM * 2);
  hp.oproj = (float*)take((size_t)NTOK * DM * 4);
  hp.bar = (unsigned*)take(XCD_BAR_WORDS * 4);
  hp.h = (bf16_t*)take((size_t)NTOK * DM * 2);
  hp.Kc = (bf16_t*)take((size_t)16 * 256 * 256 * 2);
  hp.Kl = (bf16_t*)take((size_t)8 * 1536 * 256 * 2);
  hp.Vc = (bf16_t*)take((size_t)16 * 256 * 256 * 2);
  hp.Vl = (bf16_t*)take((size_t)8 * 1536 * 256 * 2);
  {
    const size_t h_off = (size_t)((unsigned char*)hp.h - w);
    const size_t need = h_off + (size_t)(3072 - 877) * 28672;
    if (off < need) off = need;
  }
  if (off > ws_size) { fprintf(stderr, "workspace too small: need %zu have %zu\n", off, ws_size); return; }
  (void)hipMemsetAsync(hp.bar, 0, XCD_BAR_WORDS * 4, stream);
#if MULTI_LAUNCH
  for (int ph = 0; ph < NPHASE; ++ph) {
    hp.ph_lo = ph; hp.ph_hi = ph + 1; hp.coop = 0;
    hipLaunchKernelGGL(mega, dim3(grid), dim3(NTHR), LDS_BYTES, stream, hp);
  }
#else
  hp.ph_lo = 0; hp.ph_hi = NPHASE; hp.coop = 1;
  void* args[] = {&hp};
  hipError_t e = hipLaunchCooperativeKernel((const void*)mega, dim3(grid), dim3(NTHR), args, LDS_BYTES, stream);
  if (e != hipSuccess) fprintf(stderr, "cooperative launch failed: %s (grid %d)\n", hipGetErrorString(e), grid);
#endif
}
```

```cpp
#include <hip/hip_runtime.h>
#include <hip/hip_cooperative_groups.h>
#include <cstdio>
#include <cstdint>
namespace cg = cooperative_groups;

#ifndef MULTI_LAUNCH
#define MULTI_LAUNCH 0
#endif
#define REP_PREP 1
#define REP_GEMM 1
#define REP_SCAN 1
#define REP_CHAIN 1
#define REP_COMB 1
#define REP_ATT 1
#define EXTRA_SYNC 0

typedef unsigned short bf16_t;
typedef short bf16x8 __attribute__((ext_vector_type(8)));
typedef short bf16x4 __attribute__((ext_vector_type(4)));
typedef float f32x4 __attribute__((ext_vector_type(4)));
typedef float f32x16 __attribute__((ext_vector_type(16)));

#define DI __device__ __forceinline__

constexpr int DM = 1024;
constexpr int NTOK = 12288;
constexpr int NCTX = 4096;
constexpr int ZN_REC = 3584;
constexpr int ZN_ATT = 2560;
constexpr int NTHR = 512;
constexpr int LDS_BYTES = 131072;
constexpr float EPS = 1e-6f;
constexpr int NPHASE = 24;

struct Params;
typedef const __attribute__((address_space(4))) Params* PP;
struct Params {
  const float *x_prompt, *x_sample, *c, *state, *cache_k, *cache_v, *c_ctx, *ada_w, *ada_b, *norm_pre, *norm_post;
  const float *rec_w_in, *rec_lb, *rec_head_norm, *pool_w, *pool_scale, *rec_w_out, *att_w_in, *att_q_norm, *att_k_norm, *att_w_out;
  float* out;
  bf16_t *WrecT, *WrecoT, *WattT, *WattoT;
  float *mod, *lb, *ropec, *ropes;
  bf16_t *h, *z, *r;
  float* oproj;
  bf16_t *Kc, *Kl, *Vc, *Vl;
  unsigned* bar;
  int ph_lo, ph_hi, coop, pad;
};

DI bf16_t f2bf(float f) { unsigned u = __float_as_uint(f); u += 0x7fffu + ((u >> 16) & 1u); return (bf16_t)(u >> 16); }
DI float bf2f(bf16_t b) { return __uint_as_float(((unsigned)b) << 16); }
DI float bfs(short b) { return __uint_as_float(((unsigned)(unsigned short)b) << 16); }
typedef __bf16 bf16v2_t __attribute__((ext_vector_type(2)));
typedef float f32v2_t __attribute__((ext_vector_type(2)));
DI unsigned pk2(float a, float b) { f32v2_t v = {a, b}; return __builtin_bit_cast(unsigned, __builtin_convertvector(v, bf16v2_t)); }
DI float wave_sum(float v) {
  { auto r = __builtin_amdgcn_permlane32_swap(__float_as_uint(v), __float_as_uint(v), false, false); v = __uint_as_float(r[0]) + __uint_as_float(r[1]); }
  { auto r = __builtin_amdgcn_permlane16_swap(__float_as_uint(v), __float_as_uint(v), false, false); v = __uint_as_float(r[0]) + __uint_as_float(r[1]); }
  v += __uint_as_float(__builtin_amdgcn_update_dpp(0, __float_as_uint(v), 0x128, 0xf, 0xf, false));
  v += __uint_as_float(__builtin_amdgcn_update_dpp(0, __float_as_uint(v), 0x124, 0xf, 0xf, false));
  v += __uint_as_float(__builtin_amdgcn_update_dpp(0, __float_as_uint(v), 0x122, 0xf, 0xf, false));
  v += __uint_as_float(__builtin_amdgcn_update_dpp(0, __float_as_uint(v), 0x121, 0xf, 0xf, false));
  return v;
}
typedef unsigned u32x4_t __attribute__((ext_vector_type(4)));
DI void st16_wt(void* ptr, uint4 v) { u32x4_t w = {v.x, v.y, v.z, v.w}; asm volatile("global_store_dwordx4 %0, %1, off sc1\n\ts_nop 1" :: "v"(ptr), "v"(w) : "memory"); }
DI void lds_barrier() { asm volatile("s_waitcnt lgkmcnt(0)\n\ts_barrier" ::: "memory"); }
DI float silu_f(float x) { return x * __builtin_amdgcn_rcpf(1.f + __expf(-x)); }
DI f32x16 mfma32(bf16x8 a, bf16x8 b, f32x16 c) { return __builtin_amdgcn_mfma_f32_32x32x16_bf16(a, b, c, 0, 0, 0); }
DI bf16x8 pack8(const f32x16& x, int s) {
  uint4 w;
  w.x = pk2(x[8 * s + 0], x[8 * s + 1]); w.y = pk2(x[8 * s + 2], x[8 * s + 3]);
  w.z = pk2(x[8 * s + 4], x[8 * s + 5]); w.w = pk2(x[8 * s + 6], x[8 * s + 7]);
  return __builtin_bit_cast(bf16x8, w);
}

DI void tr_tile(const float* src, int ld, int k0, int n0, bf16_t* dst, int nd0, float* T) {
  const int tid = threadIdx.x;
#pragma unroll
  for (int i = 0; i < 2; ++i) {
    int idx = tid + 512 * i, kk = idx >> 4, c4 = idx & 15;
    f32x4 v = *(const f32x4*)(src + (size_t)(k0 + kk) * ld + n0 + c4 * 4);
    T[kk * 65 + c4 * 4 + 0] = v[0]; T[kk * 65 + c4 * 4 + 1] = v[1]; T[kk * 65 + c4 * 4 + 2] = v[2]; T[kk * 65 + c4 * 4 + 3] = v[3];
  }
  __syncthreads();
  {
    int nn = tid >> 3, k8 = (tid & 7) * 8;
    uint4 o;
    o.x = pk2(T[(k8 + 0) * 65 + nn], T[(k8 + 1) * 65 + nn]);
    o.y = pk2(T[(k8 + 2) * 65 + nn], T[(k8 + 3) * 65 + nn]);
    o.z = pk2(T[(k8 + 4) * 65 + nn], T[(k8 + 5) * 65 + nn]);
    o.w = pk2(T[(k8 + 6) * 65 + nn], T[(k8 + 7) * 65 + nn]);
    *(uint4*)(dst + (size_t)(nd0 + nn) * 1024 + k0 + k8) = o;
  }
  __syncthreads();
}

constexpr int J_MOD = 192, J_FOLD = 128, J_MISC = 8;
constexpr int J_TR_REC = 16 * 48, J_TR_RECO = 256, J_TR_ATT = 16 * 40, J_TR_ATTO = 256;
constexpr int J_TR_PER = J_TR_REC + J_TR_RECO + J_TR_ATT + J_TR_ATTO;
constexpr int J_TOTAL = J_MOD + J_FOLD + J_MISC + 2 * J_TR_PER;

constexpr int J_FIRST = J_MOD + J_FOLD + J_MISC;
DI int map_job(int group, int v) {
  if (group == 0) {
    if (v < 192) return v;
    v -= 192; if (v < 8) return 320 + v;
    v -= 8; if (v < 128) return 192 + v;
    v -= 128; if (v < 1024) return J_FIRST + v;
    return -1;
  } else if (group == 1) {
    return (v < 896) ? J_FIRST + 1024 + v : -1;
  } else if (group == 2) {
    return (v < 1024) ? J_FIRST + J_TR_PER + v : -1;
  } else {
    return (v < 896) ? J_FIRST + J_TR_PER + 1024 + v : -1;
  }
}
DI void prep_jobs(PP p, unsigned char* smem, int group, int vb, int nb) {
  const int tid = threadIdx.x, wave = tid >> 6, lane = tid & 63;
  int v = vb;
  for (;; v += nb) {
    const int job = map_job(group, v);
    if (job < 0 || job >= J_FIRST) break;
    int jb = job;
    if (jb < J_MOD) {
      const int i = jb / 48, col0 = (jb % 48) * 64;
      float* sv = (float*)smem;
      float* red = sv + 9 * 1024;
      for (int e = tid; e < 9 * 1024; e += NTHR) {
        int r = e >> 10, k = e & 1023;
        float cv = (r == 0) ? p->c_ctx[k] : p->c[(r - 1) * 1024 + k];
        sv[e] = silu_f(cv);
      }
      __syncthreads();
      float acc[9];
#pragma unroll
      for (int r = 0; r < 9; ++r) acc[r] = 0.f;
      const float* wp = p->ada_w + ((size_t)i * 1024 + wave * 128) * 3072 + col0 + lane;
#pragma unroll 16
      for (int k = 0; k < 128; ++k) {
        float wv = wp[(size_t)k * 3072];
#pragma unroll
        for (int r = 0; r < 9; ++r) acc[r] += sv[r * 1024 + wave * 128 + k] * wv;
      }
#pragma unroll
      for (int r = 0; r < 9; ++r) red[(wave * 9 + r) * 64 + lane] = acc[r];
      __syncthreads();
      for (int e = tid; e < 9 * 64; e += NTHR) {
        int r = e >> 6, l = e & 63;
        float s = 0.f;
#pragma unroll
        for (int w = 0; w < 8; ++w) s += red[(w * 9 + r) * 64 + l];
        p->mod[((size_t)i * 9 + r) * 3072 + col0 + l] = s + p->ada_b[i * 3072 + col0 + l];
      }
      __syncthreads();
      continue;
    }
    jb -= J_MOD;
    if (jb < J_FOLD) {
      const int j = jb >> 6, g = (jb >> 4) & 3, kt = jb & 15, k0 = kt * 64;
      float* Wt = (float*)smem;
      for (int e = tid; e < 64 * 32; e += NTHR) {
        int kk = e >> 5, c4 = e & 31;
        f32x4 v = *(const f32x4*)(p->rec_w_in + ((size_t)j * 1024 + k0 + kk) * ZN_REC + g * 128 + c4 * 4);
        Wt[kk * 129 + c4 * 4 + 0] = v[0]; Wt[kk * 129 + c4 * 4 + 1] = v[1]; Wt[kk * 129 + c4 * 4 + 2] = v[2]; Wt[kk * 129 + c4 * 4 + 3] = v[3];
      }
      __syncthreads();
      const int cp = tid & 127, kq = tid >> 7;
      float acc[16];
#pragma unroll
      for (int i = 0; i < 16; ++i) acc[i] = 0.f;
      const float* pw = p->pool_w + ((size_t)(j * 4 + g) * 128) * 128 + cp;
      for (int c = 0; c < 128; ++c) {
        float w = pw[(size_t)c * 128];
#pragma unroll
        for (int i = 0; i < 16; ++i) acc[i] += Wt[(kq * 16 + i) * 129 + c] * w;
      }
      float sc = p->pool_scale[j * 512 + g * 128 + cp];
      uint4 o0, o1;
      o0.x = pk2(acc[0] * sc, acc[1] * sc); o0.y = pk2(acc[2] * sc, acc[3] * sc); o0.z = pk2(acc[4] * sc, acc[5] * sc); o0.w = pk2(acc[6] * sc, acc[7] * sc);
      o1.x = pk2(acc[8] * sc, acc[9] * sc); o1.y = pk2(acc[10] * sc, acc[11] * sc); o1.z = pk2(acc[12] * sc, acc[13] * sc); o1.w = pk2(acc[14] * sc, acc[15] * sc);
      bf16_t* dp = p->WrecT + ((size_t)j * ZN_REC + g * 128 + cp) * 1024 + k0 + kq * 16;
      *(uint4*)dp = o0; *(uint4*)(dp + 8) = o1;
      __syncthreads();
      continue;
    }
    jb -= J_FOLD;
    if (jb < J_MISC) {
      for (int e = tid; e < 128 * 64; e += NTHR) {
        int t = jb * 128 + (e >> 6), i = e & 63;
        int fi = i & 31;
        float inv = exp2f(-(float)(2 * fi) * (13.287712379549449f / 64.f));
        float pos = (i < 32) ? (float)(t >> 6) : (float)(t & 63);
        float ang = pos * inv;
        p->ropec[t * 64 + i] = __cosf(ang);
        p->ropes[t * 64 + i] = __sinf(ang);
      }
      if (jb == 0) {
        for (int e = tid; e < 1024; e += NTHR) {
          float a0 = p->rec_lb[e], a1 = p->rec_lb[1024 + e];
          float mx = fmaxf(a0, a1);
          float e0 = __expf(a0 - mx), e1 = __expf(a1 - mx);
          float p1 = e1 / (e0 + e1);
          p->lb[e] = 0.f;
          p->lb[1024 + e] = fminf(fmaxf(p1, 0.f), 1.f);
        }
      }
      continue;
    }
  }
  {
    int job = map_job(group, v);
    float* T = (float*)smem;
    const float* src = nullptr; bf16_t* dst = nullptr; int ld = 0;
    f32x4 v0, v1;
#define TR_DECODE(jobid) do { int jb_ = (jobid) - J_FIRST; const int j_ = jb_ / J_TR_PER; int t_ = jb_ % J_TR_PER; int kt_, nt_; \
      if (t_ < J_TR_REC) { kt_ = t_ / 48; nt_ = t_ % 48 + 8; ld = ZN_REC; src = p->rec_w_in + (size_t)j_ * 1024 * ZN_REC; dst = p->WrecT + (size_t)j_ * ZN_REC * 1024; } \
      else if ((t_ -= J_TR_REC) < J_TR_RECO) { kt_ = t_ / 16; nt_ = t_ % 16; ld = 1024; src = p->rec_w_out + (size_t)j_ * 1024 * 1024; dst = p->WrecoT + (size_t)j_ * 1024 * 1024; } \
      else if ((t_ -= J_TR_RECO) < J_TR_ATT) { kt_ = t_ / 40; nt_ = t_ % 40; ld = ZN_ATT; src = p->att_w_in + (size_t)j_ * 1024 * ZN_ATT; dst = p->WattT + (size_t)j_ * ZN_ATT * 1024; } \
      else { t_ -= J_TR_ATT; kt_ = t_ / 16; nt_ = t_ % 16; ld = 1024; src = p->att_w_out + (size_t)j_ * 1024 * 1024; dst = p->WattoT + (size_t)j_ * 1024 * 1024; } \
      src += (size_t)(kt_ * 64) * ld + nt_ * 64; dst += (size_t)(nt_ * 64) * 1024 + kt_ * 64; } while (0)
#define TR_LOAD() do { v0 = *(const f32x4*)(src + (size_t)(tid >> 4) * ld + (tid & 15) * 4); v1 = *(const f32x4*)(src + (size_t)((tid >> 4) + 32) * ld + (tid & 15) * 4); } while (0)
    if (job >= 0) { TR_DECODE(job); TR_LOAD(); }
    while (job >= 0) {
      bf16_t* dcur = dst;
      {
        const int kk = tid >> 4, c4 = tid & 15;
        T[kk * 65 + c4 * 4 + 0] = v0[0]; T[kk * 65 + c4 * 4 + 1] = v0[1]; T[kk * 65 + c4 * 4 + 2] = v0[2]; T[kk * 65 + c4 * 4 + 3] = v0[3];
        T[(kk + 32) * 65 + c4 * 4 + 0] = v1[0]; T[(kk + 32) * 65 + c4 * 4 + 1] = v1[1]; T[(kk + 32) * 65 + c4 * 4 + 2] = v1[2]; T[(kk + 32) * 65 + c4 * 4 + 3] = v1[3];
      }
      lds_barrier();
      v += nb; job = map_job(group, v);
      if (job >= 0) { TR_DECODE(job); TR_LOAD(); }
      {
        const int nn = tid >> 3, k8 = (tid & 7) * 8;
        uint4 o;
        o.x = pk2(T[(k8 + 0) * 65 + nn], T[(k8 + 1) * 65 + nn]);
        o.y = pk2(T[(k8 + 2) * 65 + nn], T[(k8 + 3) * 65 + nn]);
        o.z = pk2(T[(k8 + 4) * 65 + nn], T[(k8 + 5) * 65 + nn]);
        o.w = pk2(T[(k8 + 6) * 65 + nn], T[(k8 + 7) * 65 + nn]);
        *(uint4*)(dcur + (size_t)nn * 1024 + k8) = o;
      }
      lds_barrier();
    }
#undef TR_DECODE
#undef TR_LOAD
  }
  __syncthreads();
}

#define ROW_ST16(BASE, Q) do { _Pragma("unroll") for (int jp_ = 0; jp_ < 2; ++jp_) { \
    const uint2 mine0_ = (Q)[2 * jp_], mine1_ = (Q)[2 * jp_ + 1]; const bool odd_ = lane & 1; \
    const unsigned sx_ = odd_ ? mine0_.x : mine1_.x, sy_ = odd_ ? mine0_.y : mine1_.y; \
    const unsigned rx_ = (unsigned)__builtin_amdgcn_update_dpp(0, (int)sx_, 0xB1, 0xf, 0xf, false), ry_ = (unsigned)__builtin_amdgcn_update_dpp(0, (int)sy_, 0xB1, 0xf, 0xf, false); \
    const uint4 w_ = odd_ ? make_uint4(rx_, ry_, mine1_.x, mine1_.y) : make_uint4(mine0_.x, mine0_.y, rx_, ry_); \
    st16_wt((BASE) + (size_t)row * DM + (lane & ~1) * 4 + (2 * jp_ + (odd_ ? 1 : 0)) * 256, w_); } } while (0)
DI void phase_row(PP p, int li) {
  const int wave = threadIdx.x >> 6, lane = threadIdx.x & 63;
  const int nl = li + 1;
  bf16_t* xz = p->z + (size_t)NTOK * ZN_ATT;
  bf16_t* xy = (bf16_t*)p->out;
  const bf16_t* xsrc = (li == 2) ? xy : xz;
  bf16_t* xdst = (li == 1) ? xy : xz;
  for (int pi = blockIdx.x * 8 + wave; pi < NTOK / 2; pi += gridDim.x * 8) {
    const int row0 = 2 * pi;
    const int mr = (row0 < NCTX) ? 0 : 1 + ((row0 - NCTX) >> 10);
    f32x4 x[2][4], o[2][4], gt[4], npo[4], sh[4], sc[4], npr[4];
#pragma unroll
    for (int r = 0; r < 2; ++r) {
      const int row = row0 + r;
      if (li <= 0) {
        const float* xin = (row < NCTX) ? p->x_prompt + (size_t)row * DM : p->x_sample + (size_t)(row - NCTX) * DM;
#pragma unroll
        for (int j = 0; j < 4; ++j) x[r][j] = *(const f32x4*)(xin + lane * 4 + j * 256);
      } else {
#pragma unroll
        for (int j = 0; j < 4; ++j) {
          const uint2 ux = *(const uint2*)(xsrc + (size_t)row * DM + lane * 4 + j * 256);
          x[r][j] = (f32x4){__uint_as_float(ux.x << 16), __uint_as_float(ux.x & 0xffff0000u), __uint_as_float(ux.y << 16), __uint_as_float(ux.y & 0xffff0000u)};
        }
      }
      if (li >= 0) {
#pragma unroll
        for (int j = 0; j < 4; ++j) {
          const uint2 uo = *(const uint2*)((const bf16_t*)p->oproj + (size_t)row * DM + lane * 4 + j * 256);
          o[r][j] = (f32x4){__uint_as_float(uo.x << 16), __uint_as_float(uo.x & 0xffff0000u), __uint_as_float(uo.y << 16), __uint_as_float(uo.y & 0xffff0000u)};
        }
      }
    }
    if (li >= 0) {
#pragma unroll
      for (int j = 0; j < 4; ++j) {
        gt[j] = *(const f32x4*)(p->mod + ((size_t)li * 9 + mr) * 3072 + 2048 + lane * 4 + j * 256);
        npo[j] = *(const f32x4*)(p->norm_post + li * DM + lane * 4 + j * 256);
      }
    }
    if (nl < 4) {
#pragma unroll
      for (int j = 0; j < 4; ++j) {
        sh[j] = *(const f32x4*)(p->mod + ((size_t)nl * 9 + mr) * 3072 + lane * 4 + j * 256);
        sc[j] = *(const f32x4*)(p->mod + ((size_t)nl * 9 + mr) * 3072 + 1024 + lane * 4 + j * 256);
        npr[j] = *(const f32x4*)(p->norm_pre + nl * DM + lane * 4 + j * 256);
      }
    }
    if (li >= 0) {
      float ss[2];
#pragma unroll
      for (int r = 0; r < 2; ++r) {
        float s_ = 0.f;
#pragma unroll
        for (int j = 0; j < 4; ++j) s_ += o[r][j][0] * o[r][j][0] + o[r][j][1] * o[r][j][1] + o[r][j][2] * o[r][j][2] + o[r][j][3] * o[r][j][3];
        ss[r] = s_;
      }
      ss[0] = wave_sum(ss[0]); ss[1] = wave_sum(ss[1]);
#pragma unroll
      for (int r = 0; r < 2; ++r) {
        const float rstd = rsqrtf(ss[r] * (1.f / DM) + EPS);
#pragma unroll
        for (int j = 0; j < 4; ++j) x[r][j] = x[r][j] + gt[j] * (o[r][j] * rstd * npo[j]);
      }
    }
    uint2 hq[2][4];
    if (nl < 4) {
      float ss[2];
#pragma unroll
      for (int r = 0; r < 2; ++r) {
        float s_ = 0.f;
#pragma unroll
        for (int j = 0; j < 4; ++j) s_ += x[r][j][0] * x[r][j][0] + x[r][j][1] * x[r][j][1] + x[r][j][2] * x[r][j][2] + x[r][j][3] * x[r][j][3];
        ss[r] = s_;
      }
      ss[0] = wave_sum(ss[0]); ss[1] = wave_sum(ss[1]);
#pragma unroll
      for (int r = 0; r < 2; ++r) {
        const float rstd = rsqrtf(ss[r] * (1.f / DM) + EPS);
#pragma unroll
        for (int j = 0; j < 4; ++j) {
          f32x4 hv = x[r][j] * rstd * npr[j] * (sc[j] + 1.f) + sh[j];
          hq[r][j].x = pk2(hv[0], hv[1]); hq[r][j].y = pk2(hv[2], hv[3]);
        }
      }
    }
#pragma unroll
    for (int r = 0; r < 2; ++r) {
      const int row = row0 + r;
      if (li == 3) {
#pragma unroll
        for (int j = 0; j < 4; ++j) *(f32x4*)(p->out + (size_t)row * DM + lane * 4 + j * 256) = x[r][j];
      } else if (li >= 0) {
        uint2 xq[4];
#pragma unroll
        for (int j = 0; j < 4; ++j) { xq[j].x = pk2(x[r][j][0], x[r][j][1]); xq[j].y = pk2(x[r][j][2], x[r][j][3]); }
        ROW_ST16(xdst, xq);
      }
      if (nl < 4) ROW_ST16(p->h, hq[r]);
    }
  }
}

#define LAS __attribute__((address_space(3)))
constexpr int BM = 256, BK = 64, HALF = 128, HTB = HALF * BK * 2, NXCD = 8, WGM = 8;
DI int lds_byte(int r, int c) { const int st = (r >> 4) * 2 + (c >> 5), rr = r & 15, cc = c & 31, ob = rr * 64 + cc * 2; return st * 1024 + (ob ^ (((ob >> 9) & 1) << 5)); }
DI void stage_rc(int b, int& R, int& C) { const int st = b / 1024, sb = b % 1024, swz = sb ^ (((sb >> 9) & 1) << 5); R = (st >> 1) * 16 + swz / 64; C = (st & 1) * 32 + (swz % 64) / 2; }
DI int perm32(int rho) { const int n = rho >> 4, i = rho & 15; return 8 * (i >> 2) + 4 * n + (i & 3); }
struct Unit { int pm, pn; };
struct StaticOrder {
  int nM, nN, nwg, G, c;
  DI void init(int M, int N, int G_, int c_) { nM = M / BM; nN = N / BM; nwg = nM * nN; G = G_; c = c_; }
  DI bool next(int i, Unit& u) const {
    const long L = (long)i * G + c; if (L >= nwg) return false;
    int wgid = (int)L; { const int q = nwg / NXCD, r = nwg % NXCD, xcd = wgid % NXCD, off = wgid / NXCD; wgid = (xcd < r ? xcd * (q + 1) : r * (q + 1) + (xcd - r) * q) + off; }
    const int nig = WGM * nN, gid = wgid / nig, fm = gid * WGM, gsz = (nM - fm) < WGM ? (nM - fm) : WGM;
    u.pm = fm + ((wgid % nig) % gsz); u.pn = (wgid % nig) / gsz; return true;
  }
};
struct EpiF32 {
  static constexpr bool PERM = false;
  float* C; int ldc;
  DI void operator()(const f32x4 (&acc)[2][2][4][2], const Unit& u, int wr, int wc, int fr, int fq) const {
    const int row0 = u.pm * BM + wr * 64 + fr, col0 = u.pn * BM + wc * 32 + 4 * fq;
#pragma unroll
    for (int ai = 0; ai < 2; ++ai)
#pragma unroll
      for (int m = 0; m < 4; ++m) { float* rowp = C + (size_t)(row0 + ai * HALF + m * 16) * ldc + col0;
#pragma unroll
        for (int bj = 0; bj < 2; ++bj)
#pragma unroll
          for (int n = 0; n < 2; ++n) *(f32x4*)(rowp + bj * HALF + n * 16) = acc[ai][bj][m][n]; }
  }
};
struct EpiBf16 {
  static constexpr bool PERM = true;
  bf16_t* O; int ldc;
  DI void operator()(const f32x4 (&acc)[2][2][4][2], const Unit& u, int wr, int wc, int fr, int fq) const {
    const int row0 = u.pm * BM + wr * 64 + fr, col0 = u.pn * BM + wc * 32 + 8 * fq;
#pragma unroll
    for (int ai = 0; ai < 2; ++ai)
#pragma unroll
      for (int m = 0; m < 4; ++m) { bf16_t* rowp = O + (size_t)(row0 + ai * HALF + m * 16) * ldc + col0;
#pragma unroll
        for (int bj = 0; bj < 2; ++bj) { const f32x4 v0 = acc[ai][bj][m][0], v1 = acc[ai][bj][m][1];
          uint4 o; o.x = pk2(v0[0], v0[1]); o.y = pk2(v0[2], v0[3]); o.z = pk2(v1[0], v1[1]); o.w = pk2(v1[2], v1[3]);
          st16_wt(rowp + bj * HALF, o); } }
  }
};

template <class Epi>
DI void phase_gemm(const bf16_t* gA, const bf16_t* gBt, int N, const Epi& E, unsigned char* smem) {
  LAS unsigned char* lds = (LAS unsigned char*)smem;
  StaticOrder S; S.init(NTOK, N, (int)gridDim.x, (int)blockIdx.x);
  const int tid = threadIdx.x, wid = __builtin_amdgcn_readfirstlane(tid >> 6), lane = tid & 63, wr = wid >> 2, wc = wid & 3, fr = lane & 15, fq = lane >> 4;
  constexpr int K = 1024, nt = K / BK;
  unsigned voffA[2], voffB[2];
#pragma unroll
  for (int i = 0; i < 2; ++i) { int R, C; stage_rc(tid * 16 + i * 8192, R, C); const int Rb = Epi::PERM ? ((R & ~31) + perm32(R & 31)) : R;
    voffA[i] = (unsigned)(R * K + C) * 2u; voffB[i] = (unsigned)(Rb * K + C) * 2u; }
  const size_t kstep = (size_t)(BK * 2);
  const size_t hstep = (size_t)HALF * K * 2;
  const size_t tstep = 2 * hstep;
  const unsigned ldsw = (unsigned)wid * 1024u;
  const int aoff = lds_byte(wr * 64 + fr, fq * 8), boff = lds_byte(wc * 32 + fr, fq * 8);
#define PG8_SA(b, h) (((b) * 2 + (h)) * HTB)
#define PG8_SB(b, h) ((4 + (b) * 2 + (h)) * HTB)
#define PG8_STAGE(bufoff, gbase, voff) do { _Pragma("unroll") for (int _i = 0; _i < 2; ++_i) \
    __builtin_amdgcn_global_load_lds((const unsigned*)((const char*)(gbase) + (voff)[_i]), (LAS unsigned*)(lds + (bufoff) + ldsw + _i * 8192), 16, 0, 0); } while (0)
#define PG8_LDA(dst, b, h) do { _Pragma("unroll") for (int m = 0; m < 4; ++m) _Pragma("unroll") for (int k = 0; k < 2; ++k) dst[m][k] = *(const LAS bf16x8*)(lds + PG8_SA(b, h) + aoff + m * 2048 + k * 1024); } while (0)
#define PG8_LDB(dst, b, h) do { _Pragma("unroll") for (int n = 0; n < 2; ++n) _Pragma("unroll") for (int k = 0; k < 2; ++k) dst[n][k] = *(const LAS bf16x8*)(lds + PG8_SB(b, h) + boff + n * 2048 + k * 1024); } while (0)
#define PG8_MMA(ai, bj, At, Bt) do { __builtin_amdgcn_s_setprio(1); _Pragma("unroll") for (int m = 0; m < 4; ++m) _Pragma("unroll") for (int n = 0; n < 2; ++n) _Pragma("unroll") for (int k = 0; k < 2; ++k) \
    acc[ai][bj][m][n] = __builtin_amdgcn_mfma_f32_16x16x32_bf16(Bt[n][k], At[m][k], acc[ai][bj][m][n], 0, 0, 0); __builtin_amdgcn_s_setprio(0); } while (0)
#define PG8_WAIT_V(n) asm volatile("s_waitcnt vmcnt(" #n ")" ::: "memory")
#define PG8_WAIT_L(n) asm volatile("s_waitcnt lgkmcnt(" #n ")" ::: "memory")
#define PG8_BAR __builtin_amdgcn_s_barrier()
#define PG8_SCHED __builtin_amdgcn_sched_barrier(0)
  Unit cur, nxt; int ui = 0;
  if (S.next(0, cur)) {
    f32x4 acc[2][2][4][2];
#pragma unroll
    for (int a = 0; a < 2; ++a)
#pragma unroll
      for (int b = 0; b < 2; ++b)
#pragma unroll
        for (int m = 0; m < 4; ++m)
#pragma unroll
          for (int n = 0; n < 2; ++n) acc[a][b][m][n] = (f32x4){0.f, 0.f, 0.f, 0.f};
    bf16x8 At[4][2], B0[2][2], B1[2][2];
    const char* cA = (const char*)gA + (size_t)cur.pm * tstep; const char* cB = (const char*)gBt + (size_t)cur.pn * tstep;
    PG8_STAGE(PG8_SB(0, 0), cB, voffB); PG8_STAGE(PG8_SA(0, 0), cA, voffA); PG8_STAGE(PG8_SB(0, 1), cB + hstep, voffB); PG8_STAGE(PG8_SA(0, 1), cA + hstep, voffA);
    if (wr == 1) PG8_BAR;
    PG8_WAIT_V(4); PG8_BAR;
    PG8_STAGE(PG8_SB(1, 0), cB + kstep, voffB); PG8_STAGE(PG8_SA(1, 0), cA + kstep, voffA); PG8_STAGE(PG8_SB(1, 1), cB + hstep + kstep, voffB);
    PG8_WAIT_V(6); PG8_BAR;
    for (;;) {
      const bool has_next = S.next(ui + 1, nxt);
      const char* nA = has_next ? (const char*)gA + (size_t)nxt.pm * tstep : cA; const char* nB = has_next ? (const char*)gBt + (size_t)nxt.pn * tstep : cB;
      for (int t = 0; t < nt; t += 2) {
        const bool last = (t == nt - 2);
        const char* a1 = cA + (size_t)(t + 1) * kstep;
        const char* a2 = last ? nA : cA + (size_t)(t + 2) * kstep; const char* b2 = last ? nB : cB + (size_t)(t + 2) * kstep;
        const char* a3 = a2 + kstep; const char* b3 = b2 + kstep;
        PG8_LDB(B0, 0, 0); PG8_SCHED; PG8_LDA(At, 0, 0); PG8_STAGE(PG8_SA(1, 1), a1 + hstep, voffA);
        PG8_WAIT_L(8); PG8_BAR; PG8_WAIT_L(0); PG8_MMA(0, 0, At, B0); PG8_BAR; PG8_SCHED;
        PG8_LDB(B1, 0, 1); PG8_STAGE(PG8_SB(0, 0), b2, voffB);
        PG8_BAR; PG8_WAIT_L(0); PG8_MMA(0, 1, At, B1); PG8_BAR;
        PG8_LDA(At, 0, 1); PG8_STAGE(PG8_SA(0, 0), a2, voffA);
        PG8_BAR; PG8_WAIT_L(0); PG8_MMA(1, 0, At, B0); PG8_BAR; PG8_SCHED;
        PG8_STAGE(PG8_SB(0, 1), b2 + hstep, voffB);
        PG8_WAIT_V(6); PG8_BAR; PG8_MMA(1, 1, At, B1); PG8_BAR;
        PG8_LDB(B0, 1, 0); PG8_SCHED; PG8_LDA(At, 1, 0); PG8_STAGE(PG8_SA(0, 1), a2 + hstep, voffA);
        PG8_WAIT_L(8); PG8_BAR; PG8_WAIT_L(0); PG8_MMA(0, 0, At, B0); PG8_BAR; PG8_SCHED;
        PG8_LDB(B1, 1, 1); PG8_STAGE(PG8_SB(1, 0), b3, voffB);
        PG8_BAR; PG8_WAIT_L(0); PG8_MMA(0, 1, At, B1); PG8_BAR;
        PG8_LDA(At, 1, 1); PG8_STAGE(PG8_SA(1, 0), a3, voffA);
        PG8_BAR; PG8_WAIT_L(0); PG8_MMA(1, 0, At, B0); PG8_BAR; PG8_SCHED;
        PG8_STAGE(PG8_SB(1, 1), b3 + hstep, voffB);
        PG8_WAIT_V(6); PG8_BAR; PG8_MMA(1, 1, At, B1); PG8_BAR;
      }
      E(acc, cur, wr, wc, fr, fq);
      if (!has_next) break;
#pragma unroll
      for (int a = 0; a < 2; ++a)
#pragma unroll
        for (int b = 0; b < 2; ++b)
#pragma unroll
          for (int m = 0; m < 4; ++m)
#pragma unroll
            for (int n = 0; n < 2; ++n) acc[a][b][m][n] = (f32x4){0.f, 0.f, 0.f, 0.f};
      cur = nxt; cA = nA; cB = nB; ++ui;
    }
    PG8_WAIT_V(0);
    if (wr == 0) PG8_BAR;
    PG8_BAR;
  }
  __syncthreads();
#undef PG8_SA
#undef PG8_SB
#undef PG8_STAGE
#undef PG8_LDA
#undef PG8_LDB
#undef PG8_MMA
}

constexpr int REC_BYTES = 28672, REC_QF = 0, REC_KF = 8192, REC_VF = 16384, REC_PF = 24576, REC_AL = 26624;
constexpr int N_REC_A = 877;
DI unsigned char* rec_ptr(PP p, int it) {
  return (it < N_REC_A) ? ((unsigned char*)p->oproj + (size_t)NTOK * 512 * 4 + (size_t)it * REC_BYTES)
                        : ((unsigned char*)p->h + (size_t)(it - N_REC_A) * REC_BYTES);
}
struct PrepSlot { float* LF; bf16_t *Qin, *Qt, *Kt, *KoT, *VT; float *AL, *EM, *ELM; };
DI PrepSlot prep_slot(unsigned char* smem, int s) {
  unsigned char* b = smem + s * 61440;
  PrepSlot L;
  L.LF = (float*)b;
  L.Qin = (bf16_t*)(b + 16384);
  L.Qt = L.Qin + 32 * 136;
  L.Kt = L.Qt + 32 * 136;
  L.KoT = L.Kt + 32 * 136;
  L.VT = L.KoT + 32 * 136;
  L.AL = (float*)(L.VT + 32 * 136);
  L.EM = L.AL + 128;
  L.ELM = L.EM + 128;
  return L;
}
struct PrepRegs { bf16x8 q8, f8, v8; f32x4 lwa, lwb; };
DI void prep_load(PP p, int j, int item, int t, int d0, PrepRegs& R) {
  const int dir = item & 1, hd = (item >> 1) & 3, ck = item >> 3;
  const bf16_t* zr = p->z + (size_t)(ck * 32 + (dir ? 31 - t : t)) * ZN_REC + hd * 128 + d0;
  R.q8 = *(const bf16x8*)(zr + 1024); R.f8 = *(const bf16x8*)(zr + (dir ? 2048 : 1536)); R.v8 = *(const bf16x8*)(zr + 2560);
  const float* lp = p->lb + (j * 2 + dir) * 512 + hd * 128 + d0;
  R.lwa = *(const f32x4*)lp; R.lwb = *(const f32x4*)(lp + 4);
}
DI void prep_stepA(const PrepSlot& L, const PrepRegs& R, int t, int d0, float (&sq)[8], float (&kk)[8]) {
  float lf[8];
#pragma unroll
  for (int i = 0; i < 8; ++i) {
    const float lw = (i < 4) ? R.lwa[i & 3] : R.lwb[i & 3];
    const float zf = bfs(R.f8[i]);
    const float sg = __builtin_amdgcn_rcpf(1.f + __builtin_amdgcn_exp2f(-1.4426950408889634f * zf));
    float f = lw + (1.f - lw) * sg;
    f = fminf(fmaxf(f, 1e-6f), 1.f);
    lf[i] = __builtin_amdgcn_logf(f);
    kk[i] = 1.f - f;
    sq[i] = silu_f(bfs(R.q8[i]));
  }
  *(f32x4*)(L.LF + t * 128 + d0) = (f32x4){lf[0], lf[1], lf[2], lf[3]};
  *(f32x4*)(L.LF + t * 128 + d0 + 4) = (f32x4){lf[4], lf[5], lf[6], lf[7]};
}
DI void prep_stepC(const PrepSlot& L, bf16x8 vcur, int t, int d0, const float (&sq)[8], const float (&kk)[8]) {
  f32x4 b0 = *(f32x4*)(L.LF + t * 128 + d0), b1 = *(f32x4*)(L.LF + t * 128 + d0 + 4);
  f32x4 m0 = *(f32x4*)(L.LF + 15 * 128 + d0), m1 = *(f32x4*)(L.LF + 15 * 128 + d0 + 4);
  f32x4 em0 = *(f32x4*)(L.EM + d0), em1 = *(f32x4*)(L.EM + d0 + 4);
  f32x4 el0 = *(f32x4*)(L.ELM + d0), el1 = *(f32x4*)(L.ELM + d0 + 4);
  float qi[8], qt[8], kt[8], ko[8];
#pragma unroll
  for (int i = 0; i < 8; ++i) {
    const float b = (i < 4) ? b0[i & 3] : b1[i & 3];
    const float bm = (i < 4) ? m0[i & 3] : m1[i & 3];
    const float em = (i < 4) ? em0[i & 3] : em1[i & 3];
    const float el = (i < 4) ? el0[i & 3] : el1[i & 3];
    qt[i] = sq[i] * __builtin_amdgcn_exp2f(b - bm);
    kt[i] = kk[i] * __builtin_amdgcn_exp2f(bm - b);
    qi[i] = qt[i] * em;
    ko[i] = kt[i] * el;
  }
  uint4 o;
  o.x = pk2(ko[0], ko[1]); o.y = pk2(ko[2], ko[3]); o.z = pk2(ko[4], ko[5]); o.w = pk2(ko[6], ko[7]);
  *(uint4*)(L.KoT + t * 136 + d0) = o;
  *(bf16x8*)(L.VT + t * 136 + d0) = vcur;
  o.x = pk2(qi[0], qi[1]); o.y = pk2(qi[2], qi[3]); o.z = pk2(qi[4], qi[5]); o.w = pk2(qi[6], qi[7]);
  *(uint4*)(L.Qin + t * 136 + d0) = o;
  o.x = pk2(qt[0], qt[1]); o.y = pk2(qt[2], qt[3]); o.z = pk2(qt[4], qt[5]); o.w = pk2(qt[6], qt[7]);
  *(uint4*)(L.Qt + t * 136 + d0) = o;
  o.x = pk2(kt[0], kt[1]); o.y = pk2(kt[2], kt[3]); o.z = pk2(kt[4], kt[5]); o.w = pk2(kt[6], kt[7]);
  *(uint4*)(L.Kt + t * 136 + d0) = o;
}
DI void prep_copyout(const PrepSlot& L, unsigned char* rec, int tid, int wave, int lane, int c, int hh) {
  const int f = wave, fd = f >> 1, fk = f & 1;
  {
    const bf16_t* s0 = L.Qin + c * 136 + 32 * fd + 16 * fk + 4 * hh;
    uint2 x0 = *(const uint2*)s0, x1 = *(const uint2*)(s0 + 8);
    st16_wt(rec + REC_QF + (f * 64 + lane) * 16, make_uint4(x0.x, x0.y, x1.x, x1.y));
  }
  {
    const bf16_t* k0 = L.KoT + (16 * fk + 4 * hh) * 136 + 32 * fd + c;
    const bf16_t* v0 = L.VT + (16 * fk + 4 * hh) * 136 + 32 * fd + c;
    uint4 ok, ov;
    ok.x = (unsigned)k0[0 * 136] | ((unsigned)k0[1 * 136] << 16); ok.y = (unsigned)k0[2 * 136] | ((unsigned)k0[3 * 136] << 16);
    ok.z = (unsigned)k0[8 * 136] | ((unsigned)k0[9 * 136] << 16); ok.w = (unsigned)k0[10 * 136] | ((unsigned)k0[11 * 136] << 16);
    ov.x = (unsigned)v0[0 * 136] | ((unsigned)v0[1 * 136] << 16); ov.y = (unsigned)v0[2 * 136] | ((unsigned)v0[3 * 136] << 16);
    ov.z = (unsigned)v0[8 * 136] | ((unsigned)v0[9 * 136] << 16); ov.w = (unsigned)v0[10 * 136] | ((unsigned)v0[11 * 136] << 16);
    st16_wt(rec + REC_KF + (f * 64 + lane) * 16, ok);
    st16_wt(rec + REC_VF + (f * 64 + lane) * 16, ov);
  }
  if (tid < 32) *(f32x4*)(rec + REC_AL + tid * 16) = *(const f32x4*)(L.AL + tid * 4);
}
DI void prep_intra(const PrepSlot& L, unsigned char* rec, int lane, int c, int hh) {
  f32x16 at;
#pragma unroll
  for (int q = 0; q < 16; ++q) at[q] = 0.f;
#pragma unroll
  for (int ks = 0; ks < 8; ++ks) {
    bf16x8 a = *(const bf16x8*)(L.Kt + c * 136 + ks * 16 + hh * 8);
    bf16x8 b = *(const bf16x8*)(L.Qt + c * 136 + ks * 16 + hh * 8);
    at = mfma32(a, b, at);
  }
#pragma unroll
  for (int q = 0; q < 16; ++q) {
    int sr = 8 * (q >> 2) + 4 * hh + (q & 3);
    if (sr > c) at[q] = 0.f;
  }
  st16_wt(rec + REC_PF + lane * 16, __builtin_bit_cast(uint4, pack8(at, 0)));
  st16_wt(rec + REC_PF + (64 + lane) * 16, __builtin_bit_cast(uint4, pack8(at, 1)));
}
DI void scan_prep(PP p, int j, unsigned char* smem) {
  const int tid = threadIdx.x, wave = tid >> 6, lane = tid & 63, c = lane & 31, hh = lane >> 5;
  const PrepSlot L0 = prep_slot(smem, 0), L1 = prep_slot(smem, 1);
  const int t = tid >> 4, d0 = (tid & 15) * 8;
  const int G = gridDim.x;
  int pr = blockIdx.x;
  if (pr >= 1536) return;
  PrepRegs R0, R1;
  prep_load(p, j, 2 * pr, t, d0, R0); prep_load(p, j, 2 * pr + 1, t, d0, R1);
  for (; pr < 1536; pr += G) {
    float sq0[8], kk0[8], sq1[8], kk1[8];
    const bf16x8 v0 = R0.v8, v1 = R1.v8;
    prep_stepA(L0, R0, t, d0, sq0, kk0);
    prep_stepA(L1, R1, t, d0, sq1, kk1);
    if (pr + G < 1536) { prep_load(p, j, 2 * (pr + G), t, d0, R0); prep_load(p, j, 2 * (pr + G) + 1, t, d0, R1); }
    lds_barrier();
    if (tid < 256) {
      const PrepSlot& L = (tid < 128) ? L0 : L1;
      const int d = tid & 127;
      float run = 0.f, bmid = 0.f;
#pragma unroll
      for (int tt = 0; tt < 32; ++tt) { run += L.LF[tt * 128 + d]; L.LF[tt * 128 + d] = run; if (tt == 15) bmid = run; }
      L.AL[d] = __builtin_amdgcn_exp2f(run);
      L.EM[d] = __builtin_amdgcn_exp2f(bmid);
      L.ELM[d] = __builtin_amdgcn_exp2f(run - bmid);
    }
    lds_barrier();
    prep_stepC(L0, v0, t, d0, sq0, kk0);
    prep_stepC(L1, v1, t, d0, sq1, kk1);
    lds_barrier();
    unsigned char* rec0 = rec_ptr(p, 2 * pr);
    unsigned char* rec1 = rec_ptr(p, 2 * pr + 1);
    prep_copyout(L0, rec0, tid, wave, lane, c, hh);
    prep_copyout(L1, rec1, tid, wave, lane, c, hh);
    if (wave == 0) prep_intra(L0, rec0, lane, c, hh);
    else if (wave == 1) prep_intra(L1, rec1, lane, c, hh);
    lds_barrier();
  }
}

DI void scan_chain_item(PP p, int j, int item, unsigned char* smem) {
  int s, hd, dir;
  if (item < 64) { s = 16 + (item >> 3); hd = (item >> 1) & 3; dir = item & 1; }
  else { int it = item - 64; s = it >> 3; hd = (it >> 1) & 3; dir = it & 1; }
  const int L = (s < 16) ? 256 : 1024;
  const int row0 = (s < 16) ? s * 256 : NCTX + (s - 16) * 1024;
  const int tid = threadIdx.x, wave = tid >> 6, lane = tid & 63, c = lane & 31, hh = lane >> 5;
  const int nch = L / 32, ck0 = row0 / 32;
  bf16_t* obuf = (bf16_t*)p->oproj + (dir ? (size_t)NTOK * 512 : 0);
#define REC_OF(n) rec_ptr(p, (((ck0 + (dir ? nch - 1 - (n) : (n))) * 4 + hd) * 2 + dir))
  if (wave >= 4) {
    const int lt = tid - 256;
    uint4 g0, g1, g2, g3, g4, g5, g6;
#define RG_LOAD(srcp) do { const unsigned char* s_ = (srcp) + lt * 16; g0 = *(const uint4*)(s_); g1 = *(const uint4*)(s_ + 4096); g2 = *(const uint4*)(s_ + 8192); \
    g3 = *(const uint4*)(s_ + 12288); g4 = *(const uint4*)(s_ + 16384); g5 = *(const uint4*)(s_ + 20480); g6 = *(const uint4*)(s_ + 24576); } while (0)
#define RG_STORE(dstp) do { unsigned char* d_ = (dstp) + lt * 16; *(uint4*)(d_) = g0; *(uint4*)(d_ + 4096) = g1; *(uint4*)(d_ + 8192) = g2; \
    *(uint4*)(d_ + 12288) = g3; *(uint4*)(d_ + 16384) = g4; *(uint4*)(d_ + 20480) = g5; *(uint4*)(d_ + 24576) = g6; } while (0)
    RG_LOAD(REC_OF(0));
    RG_STORE(smem);
    if (nch > 1) RG_LOAD(REC_OF(1));
    lds_barrier();
    for (int n = 0; n < nch; ++n) {
      if (n + 1 < nch) {
        RG_STORE(smem + ((n + 1) & 1) * REC_BYTES);
        if (n + 2 < nch) RG_LOAD(REC_OF(n + 2));
      }
      lds_barrier();
    }
#undef RG_LOAD
#undef RG_STORE
  } else {
    const int vs = wave;
    __builtin_amdgcn_s_setprio(3);
    f32x16 S[4];
    if (s >= 16) {
      const float* sp = p->state + ((((size_t)(s - 16) * 2 + j) * 2 + dir) * 4 + hd) * 16384;
#pragma unroll
      for (int dt = 0; dt < 4; ++dt)
#pragma unroll
        for (int q = 0; q < 16; ++q) {
          int d = 32 * dt + 8 * (q >> 2) + 4 * hh + (q & 3);
          S[dt][q] = sp[d * 128 + vs * 32 + c];
        }
    } else {
#pragma unroll
      for (int dt = 0; dt < 4; ++dt)
#pragma unroll
        for (int q = 0; q < 16; ++q) S[dt][q] = 0.f;
    }
    lds_barrier();
    for (int n = 0; n < nch; ++n) {
      const unsigned char* rb = smem + (n & 1) * REC_BYTES;
      bf16x8 qf[8];
      const bf16x8 vf0 = *(const bf16x8*)(rb + REC_VF + ((vs * 2 + 0) * 64 + lane) * 16);
      const bf16x8 vf1 = *(const bf16x8*)(rb + REC_VF + ((vs * 2 + 1) * 64 + lane) * 16);
      const bf16x8 pf0 = *(const bf16x8*)(rb + REC_PF + lane * 16);
      const bf16x8 pf1 = *(const bf16x8*)(rb + REC_PF + (64 + lane) * 16);
#pragma unroll
      for (int f = 0; f < 8; ++f) qf[f] = *(const bf16x8*)(rb + REC_QF + (f * 64 + lane) * 16);
      __builtin_amdgcn_sched_barrier(0);
      f32x16 o;
#pragma unroll
      for (int q = 0; q < 16; ++q) o[q] = 0.f;
      o = mfma32(pf0, vf0, o);
      o = mfma32(pf1, vf1, o);
#pragma unroll
      for (int f = 0; f < 8; ++f) o = mfma32(qf[f], pack8(S[f >> 1], f & 1), o);
      __builtin_amdgcn_sched_barrier(0);
      {
        const int ck = ck0 + (dir ? nch - 1 - n : n);
#pragma unroll
        for (int q = 0; q < 16; ++q) {
          const int tr = 8 * (q >> 2) + 4 * hh + (q & 3);
          const int row = ck * 32 + (dir ? 31 - tr : tr);
          obuf[(size_t)row * 512 + hd * 128 + vs * 32 + c] = (bf16_t)pk2(o[q], 0.f);
        }
      }
#pragma unroll
      for (int half = 0; half < 2; ++half) {
        bf16x8 kf[4];
        f32x4 al[8];
#pragma unroll
        for (int f = 0; f < 4; ++f) kf[f] = *(const bf16x8*)(rb + REC_KF + ((half * 4 + f) * 64 + lane) * 16);
#pragma unroll
        for (int d2 = 0; d2 < 2; ++d2)
#pragma unroll
          for (int g = 0; g < 4; ++g) al[d2 * 4 + g] = *(const f32x4*)(rb + REC_AL + (32 * (half * 2 + d2) + 8 * g + 4 * hh) * 4);
        __builtin_amdgcn_sched_barrier(0);
#pragma unroll
        for (int d2 = 0; d2 < 2; ++d2) {
          const int dt = half * 2 + d2;
#pragma unroll
          for (int g = 0; g < 4; ++g) {
            const f32x4 a4 = al[d2 * 4 + g];
            S[dt][4 * g + 0] *= a4[0]; S[dt][4 * g + 1] *= a4[1]; S[dt][4 * g + 2] *= a4[2]; S[dt][4 * g + 3] *= a4[3];
          }
          S[dt] = mfma32(kf[d2 * 2 + 0], vf0, S[dt]);
          S[dt] = mfma32(kf[d2 * 2 + 1], vf1, S[dt]);
        }
        __builtin_amdgcn_sched_barrier(0);
      }
      lds_barrier();
    }
    __builtin_amdgcn_s_setprio(0);
    if (s < 16) {
      float* op = p->out + (size_t)NTOK * DM + ((((size_t)s * 2 + j) * 2 + dir) * 4 + hd) * 16384;
#pragma unroll
      for (int dt = 0; dt < 4; ++dt)
#pragma unroll
        for (int q = 0; q < 16; ++q) {
          int d = 32 * dt + 8 * (q >> 2) + 4 * hh + (q & 3);
          op[d * 128 + vs * 32 + c] = S[dt][q];
        }
    }
  }
#undef REC_OF
  __syncthreads();
}

constexpr int R64_BYTES = 57344, R64_QF = 0, R64_KF = 16384, R64_VF = 32768, R64_PF = 49152, R64_AL = 55296;
constexpr int N_R64_A = 438;
DI unsigned char* rec64_ptr(PP p, int it) {
  return (it < N_R64_A) ? ((unsigned char*)p->oproj + (size_t)NTOK * 512 * 4 + (size_t)it * R64_BYTES)
                        : ((unsigned char*)p->h + (size_t)(it - N_R64_A) * R64_BYTES);
}
struct Prep64 { float* LF; bf16_t *Qin, *Qt, *Kt, *Ko, *Vr; float *AL, *EM, *ELM; };
DI void prep64_load(PP p, int j, int item, int t, int d0, PrepRegs& R) {
  const int dir = item & 1, hd = (item >> 1) & 3, ck = item >> 3;
  const bf16_t* zr = p->z + (size_t)(ck * 64 + (dir ? 63 - t : t)) * ZN_REC + hd * 128 + d0;
  R.q8 = *(const bf16x8*)(zr + 1024); R.f8 = *(const bf16x8*)(zr + (dir ? 2048 : 1536)); R.v8 = *(const bf16x8*)(zr + 2560);
  const float* lp = p->lb + (j * 2 + dir) * 512 + hd * 128 + d0;
  R.lwa = *(const f32x4*)lp; R.lwb = *(const f32x4*)(lp + 4);
}
DI void prep64_stepA(const Prep64& L, const PrepRegs& R, int t, int d0, float (&sq)[8], float (&kk)[8]) {
  float lf[8];
#pragma unroll
  for (int i = 0; i < 8; ++i) {
    const float lw = (i < 4) ? R.lwa[i & 3] : R.lwb[i & 3];
    const float zf = bfs(R.f8[i]);
    const float sg = __builtin_amdgcn_rcpf(1.f + __builtin_amdgcn_exp2f(-1.4426950408889634f * zf));
    float f = lw + (1.f - lw) * sg;
    f = fminf(fmaxf(f, 1e-6f), 1.f);
    lf[i] = __builtin_amdgcn_logf(f);
    kk[i] = 1.f - f;
    sq[i] = silu_f(bfs(R.q8[i]));
  }
  *(f32x4*)(L.LF + t * 128 + d0) = (f32x4){lf[0], lf[1], lf[2], lf[3]};
  *(f32x4*)(L.LF + t * 128 + d0 + 4) = (f32x4){lf[4], lf[5], lf[6], lf[7]};
}
DI void prep64_stepC(const Prep64& L, bf16x8 vcur, int t, int d0, const float (&sq)[8], const float (&kk)[8]) {
  f32x4 b0 = *(f32x4*)(L.LF + t * 128 + d0), b1 = *(f32x4*)(L.LF + t * 128 + d0 + 4);
  f32x4 m0 = *(f32x4*)(L.LF + 31 * 128 + d0), m1 = *(f32x4*)(L.LF + 31 * 128 + d0 + 4);
  f32x4 em0 = *(f32x4*)(L.EM + d0), em1 = *(f32x4*)(L.EM + d0 + 4);
  f32x4 el0 = *(f32x4*)(L.ELM + d0), el1 = *(f32x4*)(L.ELM + d0 + 4);
  float qi[8], qt[8], kt[8], ko[8];
#pragma unroll
  for (int i = 0; i < 8; ++i) {
    const float b = (i < 4) ? b0[i & 3] : b1[i & 3];
    const float bm = (i < 4) ? m0[i & 3] : m1[i & 3];
    const float em = (i < 4) ? em0[i & 3] : em1[i & 3];
    const float el = (i < 4) ? el0[i & 3] : el1[i & 3];
    qt[i] = sq[i] * __builtin_amdgcn_exp2f(b - bm);
    kt[i] = kk[i] * __builtin_amdgcn_exp2f(bm - b);
    qi[i] = qt[i] * em;
    ko[i] = kt[i] * el;
  }
  uint4 o;
  o.x = pk2(qi[0], qi[1]); o.y = pk2(qi[2], qi[3]); o.z = pk2(qi[4], qi[5]); o.w = pk2(qi[6], qi[7]);
  *(uint4*)(L.Qin + t * 136 + d0) = o;
  o.x = pk2(qt[0], qt[1]); o.y = pk2(qt[2], qt[3]); o.z = pk2(qt[4], qt[5]); o.w = pk2(qt[6], qt[7]);
  *(uint4*)(L.Qt + t * 136 + d0) = o;
  o.x = pk2(kt[0], kt[1]); o.y = pk2(kt[2], kt[3]); o.z = pk2(kt[4], kt[5]); o.w = pk2(kt[6], kt[7]);
  *(uint4*)(L.Kt + t * 136 + d0) = o;
  o.x = pk2(ko[0], ko[1]); o.y = pk2(ko[2], ko[3]); o.z = pk2(ko[4], ko[5]); o.w = pk2(ko[6], ko[7]);
  *(uint4*)(L.Ko + t * 136 + d0) = o;
  *(bf16x8*)(L.Vr + t * 136 + d0) = vcur;
}
DI void scan_prep64(PP p, int j, unsigned char* smem) {
  const int tid = threadIdx.x, wave = tid >> 6, lane = tid & 63, c = lane & 31, hh = lane >> 5;
  Prep64 L;
  L.LF = (float*)smem;
  L.Qin = (bf16_t*)(smem + 32768);
  L.Qt = L.Qin + 64 * 136; L.Kt = L.Qt + 64 * 136; L.Ko = L.Kt + 64 * 136; L.Vr = L.Ko + 64 * 136;
  L.AL = (float*)(L.Vr + 64 * 136); L.EM = L.AL + 128; L.ELM = L.EM + 128;
  const int t0 = tid >> 4, t1 = t0 + 32, d0 = (tid & 15) * 8;
  const int G = gridDim.x;
  int item = blockIdx.x;
  if (item >= 1536) return;
  PrepRegs R0, R1;
  prep64_load(p, j, item, t0, d0, R0); prep64_load(p, j, item, t1, d0, R1);
  for (; item < 1536; item += G) {
    float sq0[8], kk0[8], sq1[8], kk1[8];
    const bf16x8 v0 = R0.v8, v1 = R1.v8;
    prep64_stepA(L, R0, t0, d0, sq0, kk0);
    prep64_stepA(L, R1, t1, d0, sq1, kk1);
    if (item + G < 1536) { prep64_load(p, j, item + G, t0, d0, R0); prep64_load(p, j, item + G, t1, d0, R1); }
    lds_barrier();
    if (tid < 128) {
      float run = 0.f, bmid = 0.f;
#pragma unroll
      for (int tt = 0; tt < 64; ++tt) { run += L.LF[tt * 128 + tid]; L.LF[tt * 128 + tid] = run; if (tt == 31) bmid = run; }
      L.AL[tid] = __builtin_amdgcn_exp2f(run);
      L.EM[tid] = __builtin_amdgcn_exp2f(bmid);
      L.ELM[tid] = __builtin_amdgcn_exp2f(run - bmid);
    }
    lds_barrier();
    prep64_stepC(L, v0, t0, d0, sq0, kk0);
    prep64_stepC(L, v1, t1, d0, sq1, kk1);
    lds_barrier();
    unsigned char* rec = rec64_ptr(p, item);
#pragma unroll
    for (int e = 0; e < 2; ++e) {
      const int f = wave * 2 + e;
      {
        const int mT = f >> 3, dt = (f >> 1) & 3, k2 = f & 1;
        const bf16_t* s0 = L.Qin + (32 * mT + c) * 136 + 32 * dt + 16 * k2 + 4 * hh;
        uint2 x0 = *(const uint2*)s0, x1 = *(const uint2*)(s0 + 8);
        st16_wt(rec + R64_QF + (f * 64 + lane) * 16, make_uint4(x0.x, x0.y, x1.x, x1.y));
      }
      {
        const int fd = f >> 2, ks = f & 3;
        const bf16_t* k0 = L.Ko + (16 * ks + 4 * hh) * 136 + 32 * fd + c;
        const bf16_t* w0 = L.Vr + (16 * ks + 4 * hh) * 136 + 32 * fd + c;
        uint4 ok, ov;
        ok.x = (unsigned)k0[0 * 136] | ((unsigned)k0[1 * 136] << 16); ok.y = (unsigned)k0[2 * 136] | ((unsigned)k0[3 * 136] << 16);
        ok.z = (unsigned)k0[8 * 136] | ((unsigned)k0[9 * 136] << 16); ok.w = (unsigned)k0[10 * 136] | ((unsigned)k0[11 * 136] << 16);
        ov.x = (unsigned)w0[0 * 136] | ((unsigned)w0[1 * 136] << 16); ov.y = (unsigned)w0[2 * 136] | ((unsigned)w0[3 * 136] << 16);
        ov.z = (unsigned)w0[8 * 136] | ((unsigned)w0[9 * 136] << 16); ov.w = (unsigned)w0[10 * 136] | ((unsigned)w0[11 * 136] << 16);
        st16_wt(rec + R64_KF + (f * 64 + lane) * 16, ok);
        st16_wt(rec + R64_VF + (f * 64 + lane) * 16, ov);
      }
    }
    if (tid < 32) *(f32x4*)(rec + R64_AL + tid * 16) = *(const f32x4*)(L.AL + tid * 4);
    if (wave < 3) {
      const int sT = (wave == 2) ? 1 : 0, tT = (wave == 0) ? 0 : 1;
      f32x16 at;
#pragma unroll
      for (int q = 0; q < 16; ++q) at[q] = 0.f;
#pragma unroll
      for (int ks = 0; ks < 8; ++ks) {
        bf16x8 a = *(const bf16x8*)(L.Kt + (32 * sT + c) * 136 + ks * 16 + hh * 8);
        bf16x8 b = *(const bf16x8*)(L.Qt + (32 * tT + c) * 136 + ks * 16 + hh * 8);
        at = mfma32(a, b, at);
      }
      if (sT == tT) {
#pragma unroll
        for (int q = 0; q < 16; ++q) {
          int sr = 8 * (q >> 2) + 4 * hh + (q & 3);
          if (sr > c) at[q] = 0.f;
        }
      }
      st16_wt(rec + R64_PF + ((wave * 2 + 0) * 64 + lane) * 16, __builtin_bit_cast(uint4, pack8(at, 0)));
      st16_wt(rec + R64_PF + ((wave * 2 + 1) * 64 + lane) * 16, __builtin_bit_cast(uint4, pack8(at, 1)));
    }
    lds_barrier();
  }
}

DI void scan_chain_item64(PP p, int j, int item, unsigned char* smem) {
  int s, hd, dir;
  if (item < 64) { s = 16 + (item >> 3); hd = (item >> 1) & 3; dir = item & 1; }
  else { int it = item - 64; s = it >> 3; hd = (it >> 1) & 3; dir = it & 1; }
  const int L = (s < 16) ? 256 : 1024;
  const int row0 = (s < 16) ? s * 256 : NCTX + (s - 16) * 1024;
  const int tid = threadIdx.x, wave = tid >> 6, lane = tid & 63, c = lane & 31, hh = lane >> 5;
  const int nch = L / 64, ck0 = row0 / 64;
  bf16_t* obuf = (bf16_t*)p->oproj + (dir ? (size_t)NTOK * 512 : 0);
#define REC_OF(n) rec64_ptr(p, (((ck0 + (dir ? nch - 1 - (n) : (n))) * 4 + hd) * 2 + dir))
  if (wave >= 4) {
    const int lt = tid - 256;
    uint4 g0, g1, g2, g3, g4, g5, g6, g7, g8, g9, g10, g11, g12, g13;
#define RG_LOAD(srcp) do { const unsigned char* s_ = (srcp) + lt * 16; g0 = *(const uint4*)(s_); g1 = *(const uint4*)(s_ + 4096); g2 = *(const uint4*)(s_ + 8192); \
    g3 = *(const uint4*)(s_ + 12288); g4 = *(const uint4*)(s_ + 16384); g5 = *(const uint4*)(s_ + 20480); g6 = *(const uint4*)(s_ + 24576); \
    g7 = *(const uint4*)(s_ + 28672); g8 = *(const uint4*)(s_ + 32768); g9 = *(const uint4*)(s_ + 36864); g10 = *(const uint4*)(s_ + 40960); \
    g11 = *(const uint4*)(s_ + 45056); g12 = *(const uint4*)(s_ + 49152); g13 = *(const uint4*)(s_ + 53248); } while (0)
#define RG_STORE(dstp) do { unsigned char* d_ = (dstp) + lt * 16; *(uint4*)(d_) = g0; *(uint4*)(d_ + 4096) = g1; *(uint4*)(d_ + 8192) = g2; \
    *(uint4*)(d_ + 12288) = g3; *(uint4*)(d_ + 16384) = g4; *(uint4*)(d_ + 20480) = g5; *(uint4*)(d_ + 24576) = g6; \
    *(uint4*)(d_ + 28672) = g7; *(uint4*)(d_ + 32768) = g8; *(uint4*)(d_ + 36864) = g9; *(uint4*)(d_ + 40960) = g10; \
    *(uint4*)(d_ + 45056) = g11; *(uint4*)(d_ + 49152) = g12; *(uint4*)(d_ + 53248) = g13; } while (0)
    RG_LOAD(REC_OF(0));
    RG_STORE(smem);
    if (nch > 1) RG_LOAD(REC_OF(1));
    lds_barrier();
    for (int n = 0; n < nch; ++n) {
      if (n + 1 < nch) {
        RG_STORE(smem + ((n + 1) & 1) * R64_BYTES);
        if (n + 2 < nch) RG_LOAD(REC_OF(n + 2));
      }
      lds_barrier();
    }
#undef RG_LOAD
#undef RG_STORE
  } else {
    const int vs = wave;
    f32x16 S[4];
    if (s >= 16) {
      const float* sp = p->state + ((((size_t)(s - 16) * 2 + j) * 2 + dir) * 4 + hd) * 16384;
#pragma unroll
      for (int dt = 0; dt < 4; ++dt)
        {
#pragma unroll
          for (int q = 0; q < 16; ++q) {
            int d = 32 * dt + 8 * (q >> 2) + 4 * hh + (q & 3);
            S[dt][q] = sp[d * 128 + vs * 32 + c];
          }
          __builtin_amdgcn_sched_barrier(0);
        }
    } else {
#pragma unroll
      for (int dt = 0; dt < 4; ++dt)
#pragma unroll
        for (int q = 0; q < 16; ++q) S[dt][q] = 0.f;
    }
    lds_barrier();
    for (int n = 0; n < nch; ++n) {
      const unsigned char* rb = smem + (n & 1) * R64_BYTES;
      const int ck = ck0 + (dir ? nch - 1 - n : n);
      bf16x8 vf[4], sp8[8];
#pragma unroll
      for (int ks = 0; ks < 4; ++ks) vf[ks] = *(const bf16x8*)(rb + R64_VF + ((vs * 4 + ks) * 64 + lane) * 16);
#pragma unroll
      for (int f = 0; f < 8; ++f) sp8[f] = pack8(S[f >> 1], f & 1);
#pragma unroll
      for (int mT = 0; mT < 2; ++mT) {
        bf16x8 qf[8], pf[4];
#pragma unroll
        for (int f = 0; f < 8; ++f) qf[f] = *(const bf16x8*)(rb + R64_QF + ((mT * 8 + f) * 64 + lane) * 16);
        if (mT == 0) {
          pf[0] = *(const bf16x8*)(rb + R64_PF + (0 * 64 + lane) * 16); pf[1] = *(const bf16x8*)(rb + R64_PF + (1 * 64 + lane) * 16);
        } else {
          pf[0] = *(const bf16x8*)(rb + R64_PF + (2 * 64 + lane) * 16); pf[1] = *(const bf16x8*)(rb + R64_PF + (3 * 64 + lane) * 16);
          pf[2] = *(const bf16x8*)(rb + R64_PF + (4 * 64 + lane) * 16); pf[3] = *(const bf16x8*)(rb + R64_PF + (5 * 64 + lane) * 16);
        }
        __builtin_amdgcn_sched_barrier(0);
        f32x16 o;
#pragma unroll
        for (int q = 0; q < 16; ++q) o[q] = 0.f;
        o = mfma32(pf[0], vf[0], o);
        o = mfma32(pf[1], vf[1], o);
        if (mT == 1) { o = mfma32(pf[2], vf[2], o); o = mfma32(pf[3], vf[3], o); }
#pragma unroll
        for (int f = 0; f < 8; ++f) o = mfma32(qf[f], sp8[f], o);
        __builtin_amdgcn_sched_barrier(0);
#pragma unroll
        for (int q = 0; q < 16; ++q) {
          const int tr = 32 * mT + 8 * (q >> 2) + 4 * hh + (q & 3);
          const int row = ck * 64 + (dir ? 63 - tr : tr);
          obuf[(size_t)row * 512 + hd * 128 + vs * 32 + c] = (bf16_t)pk2(o[q], 0.f);
        }
      }
#pragma unroll
      for (int dt = 0; dt < 4; ++dt) {
        bf16x8 kf[4];
        f32x4 al[4];
#pragma unroll
        for (int ks = 0; ks < 4; ++ks) kf[ks] = *(const bf16x8*)(rb + R64_KF + ((dt * 4 + ks) * 64 + lane) * 16);
#pragma unroll
        for (int g = 0; g < 4; ++g) al[g] = *(const f32x4*)(rb + R64_AL + (32 * dt + 8 * g + 4 * hh) * 4);
#pragma unroll
        for (int g = 0; g < 4; ++g) {
          S[dt][4 * g + 0] *= al[g][0]; S[dt][4 * g + 1] *= al[g][1]; S[dt][4 * g + 2] *= al[g][2]; S[dt][4 * g + 3] *= al[g][3];
        }
#pragma unroll
        for (int ks = 0; ks < 4; ++ks) S[dt] = mfma32(kf[ks], vf[ks], S[dt]);
      }
      lds_barrier();
    }
    if (s < 16) {
      int lz = 0; asm volatile("" : "+v"(lz));
      float* op = p->out + (size_t)NTOK * DM + ((((size_t)s * 2 + j) * 2 + dir) * 4 + hd) * 16384;
#pragma unroll
      for (int dt = 0; dt < 4; ++dt)
        {
#pragma unroll
          for (int q = 0; q < 16; ++q) {
            int d = 32 * dt + 8 * (q >> 2) + 4 * hh + (q & 3);
            op[d * 128 + vs * 32 + c + lz] = S[dt][q];
          }
          __builtin_amdgcn_sched_barrier(0);
        }
    }
  }
#undef REC_OF
  __syncthreads();
}

DI void pool_job(PP p, int job, unsigned char* smem) {
  bf16_t* T = (bf16_t*)smem;
  bf16_t* Gt = T + 32 * 512;
  const int tid = threadIdx.x, cp = tid & 255, tsub = tid >> 8;
  const int g = cp >> 6, half = 1 << g;
  const int rowb = job * 16;
  const int L = (rowb < NCTX) ? 256 : 1024;
  const int seq0 = (rowb < NCTX) ? (rowb & ~255) : NCTX + ((rowb - NCTX) & ~1023);
  const int tb = rowb - seq0;
#pragma unroll
  for (int i = 0; i < 4; ++i) {
    const int e = tid + NTHR * i, r = e >> 6, c16 = e & 63, t = tb - 8 + r;
    if (t >= 0 && t < L) *(uint4*)(T + r * 512 + c16 * 8) = *(const uint4*)(p->z + (size_t)(seq0 + t) * ZN_REC + c16 * 8);
  }
#pragma unroll
  for (int i = 0; i < 2; ++i) {
    const int e = tid + NTHR * i, r = e >> 6, c16 = e & 63;
    *(uint4*)(Gt + r * 512 + c16 * 8) = *(const uint4*)(p->z + (size_t)(rowb + r) * ZN_REC + 512 + c16 * 8);
  }
  __syncthreads();
  {
    const int tl0 = tsub * 8, t0 = tb + tl0;
    int lo = max(t0 - half, 0), hi = min(t0 + half, L);
    float s0 = 0.f, s1 = 0.f;
    for (int sidx = lo; sidx < hi; ++sidx) {
      unsigned u = *(const unsigned*)(T + (sidx - tb + 8) * 512 + 2 * cp);
      s0 += __uint_as_float(u << 16); s1 += __uint_as_float(u & 0xffff0000u);
    }
#pragma unroll
    for (int i = 0; i < 8; ++i) {
      const int tl = tl0 + i, t = tb + tl, row = rowb + tl;
      const float inv = __builtin_amdgcn_rcpf((float)(hi - lo));
      const unsigned us = *(const unsigned*)(T + (tl + 8) * 512 + 2 * cp);
      const unsigned ug = *(const unsigned*)(Gt + tl * 512 + 2 * cp);
      const float y0 = (s0 * inv - __uint_as_float(us << 16)) * silu_f(__uint_as_float(ug << 16));
      const float y1 = (s1 * inv - __uint_as_float(us & 0xffff0000u)) * silu_f(__uint_as_float(ug & 0xffff0000u));
      *(unsigned*)(p->r + (size_t)row * DM + 2 * cp) = pk2(y0, y1);
      if (t + half < L) { const unsigned u = *(const unsigned*)(T + (tl + half + 8) * 512 + 2 * cp); s0 += __uint_as_float(u << 16); s1 += __uint_as_float(u & 0xffff0000u); ++hi; }
      if (t - half >= 0) { const unsigned u = *(const unsigned*)(T + (tl - half + 8) * 512 + 2 * cp); s0 -= __uint_as_float(u << 16); s1 -= __uint_as_float(u & 0xffff0000u); ++lo; }
    }
  }
  __syncthreads();
}

DI void phase_scan(PP p, int j, unsigned char* smem) {
  scan_prep64(p, j, smem);
}
DI void phase_chain(PP p, int j, unsigned char* smem) {
  const int b = blockIdx.x, G = gridDim.x;
  for (int item = b; item < 192; item += G) scan_chain_item64(p, j, item, smem);
  if (G > 64) { if (b >= 64) for (int pj = b - 64; pj < NTOK / 16; pj += G - 64) pool_job(p, pj, smem); }
  else for (int pj = b; pj < NTOK / 16; pj += G) pool_job(p, pj, smem);
}

DI void phase_combine(PP p, int j) {
  const int wave = threadIdx.x >> 6, lane = threadIdx.x & 63;
  const bf16_t* of = (const bf16_t*)p->oproj;
  const bf16_t* ob = of + (size_t)NTOK * 512;
  const float2 hn = *(const float2*)(p->rec_head_norm + j * 128 + 2 * lane);
  for (int pi = blockIdx.x * 8 + wave; pi < NTOK / 2; pi += gridDim.x * 8) {
    unsigned ua[2][4], ub[2][4], ug[2][4], res[2][4];
#pragma unroll
    for (int r = 0; r < 2; ++r)
#pragma unroll
      for (int hd = 0; hd < 4; ++hd) {
        const int row = 2 * pi + r, col = hd * 128 + 2 * lane;
        ua[r][hd] = *(const unsigned*)(of + (size_t)row * 512 + col);
        ub[r][hd] = *(const unsigned*)(ob + (size_t)row * 512 + col);
        ug[r][hd] = *(const unsigned*)(p->z + (size_t)row * ZN_REC + 3072 + col);
      }
    float o0[2][4], o1[2][4], ss[2][4];
#pragma unroll
    for (int r = 0; r < 2; ++r)
#pragma unroll
      for (int hd = 0; hd < 4; ++hd) {
        o0[r][hd] = __uint_as_float(ua[r][hd] << 16) + __uint_as_float(ub[r][hd] << 16);
        o1[r][hd] = __uint_as_float(ua[r][hd] & 0xffff0000u) + __uint_as_float(ub[r][hd] & 0xffff0000u);
        ss[r][hd] = o0[r][hd] * o0[r][hd] + o1[r][hd] * o1[r][hd];
      }
#pragma unroll
    for (int r = 0; r < 2; ++r)
#pragma unroll
      for (int hd = 0; hd < 4; ++hd) ss[r][hd] = wave_sum(ss[r][hd]);
#pragma unroll
    for (int r = 0; r < 2; ++r)
#pragma unroll
      for (int hd = 0; hd < 4; ++hd) {
        const float rstd = rsqrtf(ss[r][hd] * (1.f / 128.f) + EPS);
        const float y0 = o0[r][hd] * rstd * hn.x * silu_f(__uint_as_float(ug[r][hd] << 16));
        const float y1 = o1[r][hd] * rstd * hn.y * silu_f(__uint_as_float(ug[r][hd] & 0xffff0000u));
        res[r][hd] = pk2(y0, y1);
      }
#pragma unroll
    for (int r = 0; r < 2; ++r)
#pragma unroll
      for (int hd = 0; hd < 4; ++hd) *(unsigned*)(p->r + (size_t)(2 * pi + r) * DM + 512 + hd * 128 + 2 * lane) = res[r][hd];
  }
}

DI void vt_job(PP p, int ja, int jb, unsigned char* smem) {
  bf16_t* T = (bf16_t*)smem;
  const int tid = threadIdx.x;
  const int row = tid >> 3, cseg = (tid & 7) * 32;
  bf16_t* dst; int dstL, pos0;
  if (jb < 64) {
    const int seq = jb >> 2; pos0 = (jb & 3) * 64;
    const bf16_t* src = p->z + (size_t)(seq * 256 + pos0 + row) * ZN_ATT + 1280 + cseg;
#pragma unroll
    for (int i = 0; i < 4; ++i) {
      bf16x8 v = *(const bf16x8*)(src + i * 8);
#pragma unroll
      for (int e = 0; e < 8; ++e) T[row * 258 + cseg + i * 8 + e] = (bf16_t)v[e];
    }
    dst = p->Vc + (size_t)seq * 2 * 128 * 256; dstL = 256;
  } else {
    const int jl = jb - 64, b = jl / 24, tile = jl % 24; pos0 = tile * 64;
    if (tile < 8) {
      const float* src = p->cache_v + ((size_t)(b * 2 + ja) * 512 + pos0 + row) * 256 + cseg;
#pragma unroll
      for (int i = 0; i < 8; ++i) {
        f32x4 v = *(const f32x4*)(src + i * 4);
#pragma unroll
        for (int e = 0; e < 4; ++e) T[row * 258 + cseg + i * 4 + e] = f2bf(v[e]);
      }
    } else {
      const bf16_t* src = p->z + (size_t)(NCTX + b * 1024 + pos0 - 512 + row) * ZN_ATT + 1280 + cseg;
#pragma unroll
      for (int i = 0; i < 4; ++i) {
        bf16x8 v = *(const bf16x8*)(src + i * 8);
#pragma unroll
        for (int e = 0; e < 8; ++e) T[row * 258 + cseg + i * 8 + e] = (bf16_t)v[e];
      }
    }
    dst = p->Vl + (size_t)b * 2 * 128 * 1536; dstL = 1536;
  }
  __syncthreads();
#pragma unroll
  for (int k = 0; k < 4; ++k) {
    int piece = tid + 512 * k, orow = piece >> 3, seg = piece & 7;
    uint4 o;
    o.x = (unsigned)T[(seg * 8 + 0) * 258 + orow] | ((unsigned)T[(seg * 8 + 1) * 258 + orow] << 16);
    o.y = (unsigned)T[(seg * 8 + 2) * 258 + orow] | ((unsigned)T[(seg * 8 + 3) * 258 + orow] << 16);
    o.z = (unsigned)T[(seg * 8 + 4) * 258 + orow] | ((unsigned)T[(seg * 8 + 5) * 258 + orow] << 16);
    o.w = (unsigned)T[(seg * 8 + 6) * 258 + orow] | ((unsigned)T[(seg * 8 + 7) * 258 + orow] << 16);
    *(uint4*)(dst + (size_t)orow * dstL + pos0 + seg * 8) = o;
  }
  __syncthreads();
}

DI void phase_kvprep(PP p, int ja, unsigned char* smem) {
  const int wave = threadIdx.x >> 6, lane = threadIdx.x & 63;
  float* outk = p->out + (size_t)NTOK * DM + 4194304;
  float* outv = outk + 2097152;
  const float2 wq = *(const float2*)(p->att_q_norm + ja * 128 + 2 * lane), wk = *(const float2*)(p->att_k_norm + ja * 128 + 2 * lane);
  const int stride = gridDim.x * 8;
  {
    int row = blockIdx.x * 8 + wave;
    unsigned u[10], un[10]; uint2 uv, uvn; float cs = 1.f, sn = 0.f, csn = 1.f, snn = 0.f;
#define KV_LOAD(R, U, UV, CS, SN) do { const bf16_t* zr_ = p->z + (size_t)(R) * ZN_ATT; \
      _Pragma("unroll") for (int hq = 0; hq < 10; ++hq) U[hq] = *(const unsigned*)(zr_ + hq * 128 + 2 * lane); \
      UV = *(const uint2*)(zr_ + 1280 + 4 * lane); \
      if ((R) >= NCTX) { const int t_ = ((R) - NCTX) & 1023; CS = p->ropec[t_ * 64 + lane]; SN = p->ropes[t_ * 64 + lane]; } else { CS = 1.f; SN = 0.f; } } while (0)
    if (row < NTOK) KV_LOAD(row, u, uv, cs, sn);
    while (row < NTOK) {
      const int nrow = row + stride;
      if (nrow < NTOK) KV_LOAD(nrow, un, uvn, csn, snn);
      const bool lat = row >= NCTX;
      const int b = lat ? ((row - NCTX) >> 10) : (row >> 8);
      const int t = lat ? ((row - NCTX) & 1023) : (row & 255);
      float r1[10], r2[10];
#pragma unroll
      for (int hq = 0; hq < 10; ++hq) {
        float x1 = __uint_as_float(u[hq] << 16), x2 = __uint_as_float(u[hq] & 0xffff0000u);
        float ss = wave_sum(x1 * x1 + x2 * x2);
        float rstd = rsqrtf(ss * (1.f / 128.f) + EPS);
        float y1 = x1 * rstd * ((hq < 8) ? wq.x : wk.x), y2 = x2 * rstd * ((hq < 8) ? wq.y : wk.y);
        r1[hq] = y1 * cs - y2 * sn; r2[hq] = y1 * sn + y2 * cs;
      }
#pragma unroll
      for (int hq = 0; hq < 8; ++hq) *(unsigned*)(p->h + (size_t)row * DM + hq * 128 + 2 * lane) = pk2(r1[hq], r2[hq]);
#pragma unroll
      for (int g = 0; g < 2; ++g) {
        if (!lat) {
          *(float2*)(outk + ((size_t)(b * 2 + ja) * 256 + t) * 256 + g * 128 + 2 * lane) = make_float2(r1[8 + g], r2[8 + g]);
          *(unsigned*)(p->Kc + ((size_t)b * 256 + t) * 256 + g * 128 + 2 * lane) = pk2(r1[8 + g], r2[8 + g]);
        } else {
          *(unsigned*)(p->Kl + ((size_t)b * 1536 + 512 + t) * 256 + g * 128 + 2 * lane) = pk2(r1[8 + g], r2[8 + g]);
        }
      }
      if (!lat) {
        f32x4 v = (f32x4){__uint_as_float(uv.x << 16), __uint_as_float(uv.x & 0xffff0000u), __uint_as_float(uv.y << 16), __uint_as_float(uv.y & 0xffff0000u)};
        *(f32x4*)(outv + ((size_t)(b * 2 + ja) * 256 + t) * 256 + 4 * lane) = v;
        *(uint2*)(p->Vc + ((size_t)b * 256 + t) * 256 + 4 * lane) = uv;
      } else {
        *(uint2*)(p->Vl + ((size_t)b * 1536 + 512 + t) * 256 + 4 * lane) = uv;
      }
#pragma unroll
      for (int hq = 0; hq < 10; ++hq) u[hq] = un[hq];
      uv = uvn; cs = csn; sn = snn; row = nrow;
    }
#undef KV_LOAD
  }
  for (int cr = blockIdx.x * 8 + wave; cr < 4096; cr += 2 * stride) {
    const int cr2 = cr + stride;
    const int b = cr >> 9, pp = cr & 511, b2 = (cr2 & 4095) >> 9, pp2 = cr2 & 511;
    const bool has2 = cr2 < 4096;
    f32x4 v = *(const f32x4*)(p->cache_k + ((size_t)(b * 2 + ja) * 512 + pp) * 256 + 4 * lane);
    f32x4 w = *(const f32x4*)(p->cache_v + ((size_t)(b * 2 + ja) * 512 + pp) * 256 + 4 * lane);
    f32x4 v2 = v, w2 = w;
    if (has2) { v2 = *(const f32x4*)(p->cache_k + ((size_t)(b2 * 2 + ja) * 512 + pp2) * 256 + 4 * lane);
                w2 = *(const f32x4*)(p->cache_v + ((size_t)(b2 * 2 + ja) * 512 + pp2) * 256 + 4 * lane); }
    uint2 o; o.x = pk2(v[0], v[1]); o.y = pk2(v[2], v[3]);
    *(uint2*)(p->Kl + ((size_t)b * 1536 + pp) * 256 + 4 * lane) = o;
    o.x = pk2(w[0], w[1]); o.y = pk2(w[2], w[3]);
    *(uint2*)(p->Vl + ((size_t)b * 1536 + pp) * 256 + 4 * lane) = o;
    if (has2) {
      o.x = pk2(v2[0], v2[1]); o.y = pk2(v2[2], v2[3]);
      *(uint2*)(p->Kl + ((size_t)b2 * 1536 + pp2) * 256 + 4 * lane) = o;
      o.x = pk2(w2[0], w2[1]); o.y = pk2(w2[2], w2[3]);
      *(uint2*)(p->Vl + ((size_t)b2 * 1536 + pp2) * 256 + 4 * lane) = o;
    }
  }
}

namespace att {
using bf16 = unsigned short;
constexpr int   D = 128, NW = 8, QBLK = 32, KVBLK = 64;
constexpr float SCALE = 0.088388347648318440f;
constexpr float THR = 8.f;
constexpr int SDEPTH = 2;
constexpr int LDQ = 1024, LDK = 256, LDO = 1024, LDG = 2560;
constexpr size_t SHM_V = KVBLK * D * 2, SHM_K = KVBLK * D * 2, SHM_ATTN = 2 * SHM_V + 2 * SHM_K + NW * 64 * 4;
using s16x4  = __attribute__((ext_vector_type(4))) short;
using f32x8  = __attribute__((ext_vector_type(8))) float;
using u32x4  = __attribute__((ext_vector_type(4))) unsigned;
#define KSWZ(row, colB) ((row) * 256 + ((colB) ^ (((row) & 7) << 4)))
#define SBAR() __builtin_amdgcn_sched_barrier(0)
__device__ __forceinline__ int crow(int r, int hi) { return (r & 3) + 8 * (r >> 2) + 4 * hi; }
__device__ __forceinline__ unsigned cvtpk(float lo, float hi) {
  unsigned r; asm volatile("v_cvt_pk_bf16_f32 %0, %1, %2" : "=v"(r) : "v"(lo), "v"(hi)); return r;
}
template <typename TIn> struct Stage;
template <> struct Stage<bf16>  { using T = bf16x8;
  __device__ static __forceinline__ T ld8(const bf16* p) { return *reinterpret_cast<const bf16x8*>(p); }
  __device__ static __forceinline__ bf16x8 tobf(T x) { return x; } };
__device__ __forceinline__ void partialSM(f32x16& p0, f32x16& p1, float& m_reg, float& mn, float& alpha) {
  constexpr float C = SCALE * 1.4426950408889634f;
  float pmax = p0[0]; for (int r = 1; r < 16; ++r) pmax = fmaxf(pmax, p0[r]); for (int r = 0; r < 16; ++r) pmax = fmaxf(pmax, p1[r]);
  { auto rr = __builtin_amdgcn_permlane32_swap(__float_as_uint(pmax), __float_as_uint(pmax), false, false);
    pmax = fmaxf(__uint_as_float(rr[0]), __uint_as_float(rr[1])); }
  if (__builtin_expect(__all(pmax - m_reg <= THR / SCALE), 1)) { mn = m_reg; alpha = 1.f; }
  else { mn = fmaxf(m_reg, pmax); alpha = __builtin_amdgcn_exp2f((m_reg - mn) * C); m_reg = mn; }
  float mnC = -mn * C;
  for (int r = 0; r < 16; ++r) p0[r] = fmaf(p0[r], C, mnC); for (int r = 0; r < 16; ++r) p1[r] = fmaf(p1[r], C, mnC);
  for (int r = 0; r < 16; ++r) p0[r] = __builtin_amdgcn_exp2f(p0[r]);
}
__device__ __forceinline__ void finishSM(f32x16& p0, f32x16& p1, float alpha, float& l_reg, bf16x8& pa0, bf16x8& pa1, bf16x8& pa2, bf16x8& pa3) {
  for (int r = 0; r < 16; ++r) p1[r] = __builtin_amdgcn_exp2f(p1[r]);
  float ps = 0; for (int r = 0; r < 16; ++r) ps += p0[r]; for (int r = 0; r < 16; ++r) ps += p1[r];
  { auto rr = __builtin_amdgcn_permlane32_swap(__float_as_uint(ps), __float_as_uint(ps), false, false);
    ps = __uint_as_float(rr[0]) + __uint_as_float(rr[1]); }
  l_reg = l_reg * alpha + ps;
#define PK4(P, BASE, OUT) do { unsigned a0 = cvtpk(P[BASE + 0], P[BASE + 1]), a1 = cvtpk(P[BASE + 2], P[BASE + 3]);   \
    unsigned b0 = cvtpk(P[BASE + 4], P[BASE + 5]), b1 = cvtpk(P[BASE + 6], P[BASE + 7]);                              \
    auto r0 = __builtin_amdgcn_permlane32_swap(a0, b0, false, false); auto r1 = __builtin_amdgcn_permlane32_swap(a1, b1, false, false); \
    u32x4 w = {r0[0], r1[0], r0[1], r1[1]}; OUT = *reinterpret_cast<bf16x8*>(&w); } while (0)
  PK4(p0, 0, pa0); PK4(p0, 8, pa1); PK4(p1, 0, pa2); PK4(p1, 8, pa3);
#undef PK4
}
__device__ __forceinline__ void qkt(f32x16& p0, f32x16& p1, const bf16* Ks, const bf16x8* qr, int r32, int hi) {
  p0 = f32x16{}; p1 = f32x16{};
  for (int d0 = 0; d0 < 8; ++d0) { int cb = (d0 * 16 + hi * 8) * 2;
    bf16x8 b0 = *reinterpret_cast<const bf16x8*>((const char*)Ks + KSWZ(r32, cb));
    bf16x8 b1 = *reinterpret_cast<const bf16x8*>((const char*)Ks + KSWZ(32 + r32, cb));
    p0 = __builtin_amdgcn_mfma_f32_32x32x16_bf16(b0, qr[d0], p0, 0, 0, 0);
    p1 = __builtin_amdgcn_mfma_f32_32x32x16_bf16(b1, qr[d0], p1, 0, 0, 0); }
}
__device__ __forceinline__ int v_st(int k, int c) { const int kk = (k & ~0xC) | ((k & 4) << 1) | ((k & 8) >> 1); return ((kk >> 3) * 4 + (c >> 5)) * 512 + ((kk & 7) * 32 + (c & 31)) * 2; }
__device__ __forceinline__ int v_rd_base(int lane) { return ((lane & 3) << 3) | (((lane >> 2) & 3) << 6) | (((lane >> 4) & 1) << 5) | (((lane >> 5) & 1) << 8); }
constexpr int v_rd_off(int d0, int ks, int half) { return d0 * 512 + ks * 4096 + half * 2048; }
template <int OFF> __device__ __forceinline__ s16x4 tr_read(int vb) {
  s16x4 r; asm volatile("ds_read_b64_tr_b16 %0, %1 offset:%2" : "=&v"(r) : "v"(vb), "i"(OFF) : "memory"); return r;
}
template <int D0> __device__ __forceinline__ void pv_one(f32x16& od, int vb, bf16x8 pa0, bf16x8 pa1, bf16x8 pa2, bf16x8 pa3) {
  const s16x4 l0 = tr_read<v_rd_off(D0, 0, 0)>(vb), h0 = tr_read<v_rd_off(D0, 0, 1)>(vb), l1 = tr_read<v_rd_off(D0, 1, 0)>(vb), h1 = tr_read<v_rd_off(D0, 1, 1)>(vb);
  const s16x4 l2 = tr_read<v_rd_off(D0, 2, 0)>(vb), h2 = tr_read<v_rd_off(D0, 2, 1)>(vb), l3 = tr_read<v_rd_off(D0, 3, 0)>(vb), h3 = tr_read<v_rd_off(D0, 3, 1)>(vb);
  asm volatile("s_waitcnt lgkmcnt(0)" ::: "memory"); SBAR();
#define PK(L, H) (bf16x8){L[0], L[1], L[2], L[3], H[0], H[1], H[2], H[3]}
  od = __builtin_amdgcn_mfma_f32_32x32x16_bf16(pa0, PK(l0, h0), od, 0, 0, 0);
  od = __builtin_amdgcn_mfma_f32_32x32x16_bf16(pa1, PK(l1, h1), od, 0, 0, 0);
  od = __builtin_amdgcn_mfma_f32_32x32x16_bf16(pa2, PK(l2, h2), od, 0, 0, 0);
  od = __builtin_amdgcn_mfma_f32_32x32x16_bf16(pa3, PK(l3, h3), od, 0, 0, 0);
#undef PK
}
__device__ __forceinline__ void pv_d0(f32x16* o, int vb, bf16x8 pa0, bf16x8 pa1, bf16x8 pa2, bf16x8 pa3) {
  pv_one<0>(o[0], vb, pa0, pa1, pa2, pa3); pv_one<1>(o[1], vb, pa0, pa1, pa2, pa3); pv_one<2>(o[2], vb, pa0, pa1, pa2, pa3); pv_one<3>(o[3], vb, pa0, pa1, pa2, pa3);
}

template <typename TQ>
__device__ __forceinline__ void attn_dense_body(const TQ* __restrict__ Qb, const bf16* __restrict__ Kh, const bf16* __restrict__ Vh,
                                                const bf16* __restrict__ Gb, bf16* __restrict__ Ob, int seq, char* lds) {
  using St = Stage<bf16>; using SQ = Stage<TQ>;
  const int tid = threadIdx.x, wid = tid >> 6, lane = tid & 63, r32 = lane & 31, hi = lane >> 5;
  bf16* V_lds = (bf16*)lds; bf16* K_lds = (bf16*)(lds + 2 * SHM_V);
  float* ws = (float*)(lds + 2 * SHM_V + 2 * SHM_K) + wid * 64; float* li_l = ws; float* al_l = ws + 32;
  float m_reg = -1e30f, l_reg = 0; f32x16 o[4] = {}; bf16x8 qr[8];
  const TQ* Qw = Qb + (long)(wid * QBLK + r32) * LDQ + hi * 8;
#pragma unroll
  for (int d0 = 0; d0 < 8; ++d0) qr[d0] = SQ::tobf(SQ::ld8(Qw + d0 * 16));
  const int sr = tid >> 4, sc = (tid & 15) * 8, vst0 = v_st(sr, sc), vst1 = v_st(32 + sr, sc);
  const int vb0 = (int)(uintptr_t)V_lds + v_rd_base(lane);
  struct { typename St::T vs0, vs1, ks0, ks1; } sr_[SDEPTH];
#define SLOAD(i, k0) do { sr_[i].vs0 = St::ld8(&Vh[(long)((k0) + sr) * LDK + sc]); sr_[i].vs1 = St::ld8(&Vh[(long)((k0) + 32 + sr) * LDK + sc]); \
    sr_[i].ks0 = St::ld8(&Kh[(long)((k0) + sr) * LDK + sc]); sr_[i].ks1 = St::ld8(&Kh[(long)((k0) + 32 + sr) * LDK + sc]); } while (0)
#define SWRITE(b, i) do { *(bf16x8*)((char*)V_lds + (b) * SHM_V + vst0) = St::tobf(sr_[i].vs0);          \
    *(bf16x8*)((char*)V_lds + (b) * SHM_V + vst1) = St::tobf(sr_[i].vs1); int kc = sc * 2;               \
    *(bf16x8*)((char*)K_lds + (b) * SHM_K + KSWZ(sr, kc)) = St::tobf(sr_[i].ks0);                       \
    *(bf16x8*)((char*)K_lds + (b) * SHM_K + KSWZ(32 + sr, kc)) = St::tobf(sr_[i].ks1); } while (0)
#define SWAIT() do { if constexpr (SDEPTH == 2) asm volatile("s_waitcnt vmcnt(4)" ::: "memory"); else asm volatile("s_waitcnt vmcnt(0)" ::: "memory"); } while (0)
#define RESC(a) do { if (__any((a) < 1.f)) { if (hi == 0) al_l[r32] = (a); asm volatile("s_waitcnt lgkmcnt(0)" ::: "memory"); \
    for (int d = 0; d < 4; ++d) for (int r = 0; r < 16; ++r) o[d][r] *= al_l[crow(r, hi)]; } } while (0)
  f32x16 pA0, pA1, pB0, pB1; float mnA, mnB, alA, alB; bf16x8 pa0, pa1, pa2, pa3; const int NT = seq / KVBLK;
  constexpr int SE = 0, SO = SDEPTH - 1;
  SLOAD(SE, 0); asm volatile("s_waitcnt vmcnt(0)" ::: "memory"); SWRITE(0, SE); __syncthreads();
  qkt(pA0, pA1, K_lds, qr, r32, hi); partialSM(pA0, pA1, m_reg, mnA, alA);
  SLOAD(SO, KVBLK); if constexpr (SDEPTH == 2) { if (2 < NT) SLOAD(SE, 2 * KVBLK); }
  SWAIT(); SWRITE(1, SO); __syncthreads();
  for (int j = 1; j + 1 < NT; j += 2) {
    SBAR(); qkt(pB0, pB1, (bf16*)((char*)K_lds + SHM_K), qr, r32, hi);
    finishSM(pA0, pA1, alA, l_reg, pa0, pa1, pa2, pa3); SBAR();
    SLOAD(SO, (j + SDEPTH) * KVBLK); SBAR();
    pv_d0(o, vb0, pa0, pa1, pa2, pa3); partialSM(pB0, pB1, m_reg, mnB, alB);
    __syncthreads(); SWAIT(); SWRITE(0, SE);
    RESC(alB); __syncthreads();
    SBAR(); qkt(pA0, pA1, K_lds, qr, r32, hi);
    finishSM(pB0, pB1, alB, l_reg, pa0, pa1, pa2, pa3); SBAR();
    if (SDEPTH == 1 || j + 3 < NT) SLOAD(SE, (j + 1 + SDEPTH) * KVBLK); SBAR();
    pv_d0(o, vb0 + (int)SHM_V, pa0, pa1, pa2, pa3); partialSM(pA0, pA1, m_reg, mnA, alA);
    __syncthreads(); SWAIT(); SWRITE(1, SO);
    RESC(alA); __syncthreads();
  }
  SBAR(); qkt(pB0, pB1, (bf16*)((char*)K_lds + SHM_K), qr, r32, hi);
  finishSM(pA0, pA1, alA, l_reg, pa0, pa1, pa2, pa3); SBAR();
  pv_d0(o, vb0, pa0, pa1, pa2, pa3); partialSM(pB0, pB1, m_reg, mnB, alB);
  __syncthreads(); RESC(alB);
  finishSM(pB0, pB1, alB, l_reg, pa0, pa1, pa2, pa3); SBAR();
  pv_d0(o, vb0 + (int)SHM_V, pa0, pa1, pa2, pa3);
  if (hi == 0) li_l[r32] = l_reg; asm volatile("s_waitcnt lgkmcnt(0)" ::: "memory");
  float rli[16];
#pragma unroll
  for (int r = 0; r < 16; ++r) rli[r] = __builtin_amdgcn_rcpf(li_l[crow(r, hi)]);
  int lofs = 4 * hi; asm volatile("" : "+v"(lofs));
  const bf16* Gw = Gb + (long)(wid * QBLK + lofs) * LDG + r32; bf16* Ow = Ob + (long)(wid * QBLK + lofs) * LDO + r32;
#pragma unroll
  for (int d0 = 0; d0 < 4; ++d0) {
    unsigned short gv[16];
#pragma unroll
    for (int r = 0; r < 16; ++r) gv[r] = Gw[(long)((r & 3) + 8 * (r >> 2)) * LDG + d0 * 32];
#pragma unroll
    for (int r = 0; r < 16; ++r) {
      const float g = __uint_as_float(((unsigned)gv[r]) << 16);
      const float val = o[d0][r] * rli[r] * (g * __builtin_amdgcn_rcpf(1.f + __expf(-g)));
      Ow[(long)((r & 3) + 8 * (r >> 2)) * LDO + d0 * 32] = (bf16)(cvtpk(val, 0.f) & 0xffffu);
    }
  }
#undef SLOAD
#undef SWRITE
#undef SWAIT
#undef RESC
}

#undef KSWZ
#undef SBAR
}

DI void att_item(PP p, int qrow0, int head, const bf16_t* Kb, const bf16_t* Vb, int Lk, unsigned char* smem) {
  __syncthreads();
  att::attn_dense_body<att::bf16>(p->h + (size_t)qrow0 * DM + head * 128, Kb, Vb, p->z + (size_t)qrow0 * ZN_ATT + 1536 + head * 128,
                                  p->r + (size_t)qrow0 * DM + head * 128, Lk, (char*)smem);
}

DI void phase_att(PP p, unsigned char* smem) {
  for (int item = blockIdx.x; item < 384; item += gridDim.x) {
    int qrow0, head, Lk; const bf16_t* Kb; const bf16_t* Vb;
    if (item < 256) {
      const int xcd = item & 7, slot = item >> 3;
      const int bg = xcd * 2 + (slot >> 4), within = slot & 15;
      const int b = bg >> 1, g = bg & 1, qt = within & 3;
      head = g * 4 + (within >> 2); qrow0 = NCTX + b * 1024 + qt * 256; Lk = 1536;
      Kb = p->Kl + (size_t)b * 1536 * 256 + g * 128; Vb = p->Vl + (size_t)b * 1536 * 256 + g * 128;
    } else {
      const int id2 = item - 256, xcd = id2 & 7, slot = id2 >> 3;
      const int grp = xcd * 4 + (slot >> 2), seq = grp >> 1, g = grp & 1;
      head = g * 4 + (slot & 3); qrow0 = seq * 256; Lk = 256;
      Kb = p->Kc + (size_t)seq * 256 * 256 + g * 128; Vb = p->Vc + (size_t)seq * 256 * 256 + g * 128;
    }
    att_item(p, qrow0, head, Kb, Vb, Lk, smem);
  }
}

#define XB_TMO      128
#define XB_XCNT(j)  (256  + 64 * (j))
#define XB_XSUB(j)  (1280 + 64 * (j))
#define XB_XGEN(j)  (2304 + 64 * (j))
#define XB_TOP      3328
#define XB_TOPGEN   3392
#define XCD_BAR_WORDS 3456
#define XB_SPIN_CAP (1u << 18)
DI unsigned xb_ld(unsigned* p) { return __hip_atomic_load(p, __ATOMIC_RELAXED, __HIP_MEMORY_SCOPE_AGENT); }
DI unsigned xb_add(unsigned* p, unsigned v) { return __hip_atomic_fetch_add(p, v, __ATOMIC_RELAXED, __HIP_MEMORY_SCOPE_AGENT); }
DI unsigned xb_xcc_id() { return (unsigned)__builtin_amdgcn_s_getreg((3 << 11) | 20) & 0xFu; }
#define XB_SPIN(cond, bar) do { unsigned _sp = 0; while (cond) { __builtin_amdgcn_s_sleep(1); \
    if ((++_sp & 255u) == 0u) { if (xb_ld(&(bar)[XB_TMO])) break; if (_sp > XB_SPIN_CAP) { atomicAdd(&(bar)[XB_TMO], 1u); break; } } } } while (0)
DI void xcd_barrier_complete(unsigned* bar, unsigned x, unsigned& nloc, unsigned& nx) {
  const unsigned G = gridDim.x;
  unsigned sum, cnt, mine, sp = 0u;
  for (;;) {
    sum = 0u; cnt = 0u; mine = 0u;
#pragma unroll
    for (unsigned j = 0; j < 16; ++j) { const unsigned c = xb_ld(&bar[XB_XCNT(j)]); sum += c; cnt += (c > 0u) ? 1u : 0u; mine = (j == x) ? c : mine; }
    if (sum == G) break;
    __builtin_amdgcn_s_sleep(1);
    if ((++sp & 255u) == 0u) { if (xb_ld(&bar[XB_TMO])) break; if (sp > XB_SPIN_CAP) { atomicAdd(&bar[XB_TMO], 1u); break; } }
  }
  nloc = mine > 0u ? mine : 1u; nx = cnt > 0u ? cnt : 1u;
}
DI void xcd_barrier(unsigned* bar, volatile LAS unsigned* st) {
  asm volatile("s_waitcnt vmcnt(0)" ::: "memory");
  __syncthreads();
  if (threadIdx.x == 0) {
    const unsigned x = xb_xcc_id();
    __builtin_amdgcn_s_waitcnt(0);
    unsigned nloc = st[0], nx = st[1];
    if (nloc == 0u) { xcd_barrier_complete(bar, x, nloc, nx); st[0] = nloc; st[1] = nx; }
    const unsigned k = st[2];
    const unsigned old = xb_add(&bar[XB_XSUB(x)], 1u);
    const unsigned gen = old / nloc;
    if (old + 1u == (gen + 1u) * nloc) {
      __builtin_amdgcn_fence(__ATOMIC_RELEASE, "agent");
      asm volatile("s_waitcnt vmcnt(0)" ::: "memory");
      const unsigned og = xb_add(&bar[XB_TOP], 1u);
      const unsigned tg = og / nx;
      __builtin_amdgcn_fence(__ATOMIC_ACQUIRE, "agent");
      if (og + 1u == (tg + 1u) * nx) xb_add(&bar[XB_TOPGEN], 1u);
      else XB_SPIN(xb_ld(&bar[XB_TOPGEN]) == k, bar);
      asm volatile("s_waitcnt vmcnt(0)" ::: "memory");
    } else {
      __builtin_amdgcn_fence(__ATOMIC_ACQUIRE, "agent");
      { unsigned _sp = 0;
        while (xb_ld(&bar[XB_TOPGEN]) == k) { __builtin_amdgcn_s_sleep(3);
          if ((++_sp & 255u) == 0u) { if (xb_ld(&bar[XB_TMO])) break; if (_sp > XB_SPIN_CAP) { atomicAdd(&bar[XB_TMO], 1u); break; } } } }
      asm volatile("s_waitcnt vmcnt(0)" ::: "memory");
    }
    st[2] = k + 1u;
  }
  __syncthreads();
}

__global__ void __launch_bounds__(NTHR, 2) mega(Params p_arg) {
  extern __shared__ __attribute__((aligned(16))) unsigned char smem[];
  __shared__ uint4 xb_words;
  PP p0 = (PP)__builtin_amdgcn_kernarg_segment_ptr();
  const int ph_lo = p0->ph_lo, ph_hi = p0->ph_hi, coop = p0->coop;
  if (threadIdx.x == 0) xb_words = make_uint4(0u, 0u, 0u, 0u);
  __syncthreads();
  if (coop && threadIdx.x == 0) (void)xb_add(&p0->bar[XB_XCNT(xb_xcc_id())], 1u);
  if (p0->pad == 0x7fffffff) cg::this_grid().sync();
#define PH(k, rep, ...) { if (ph_lo <= (k) && (k) < ph_hi) { for (int rep_ = 0; rep_ < (rep); ++rep_) { PP p = (PP)__builtin_amdgcn_kernarg_segment_ptr(); asm volatile("" : "+s"(p)); __VA_ARGS__; } \
    if ((k) + 1 < ph_hi && coop) xcd_barrier(p0->bar, (volatile LAS unsigned*)&xb_words); } }
  PH(0, REP_PREP, prep_jobs(p, smem, 0, blockIdx.x, gridDim.x))
  if (coop) for (int e = 0; e < EXTRA_SYNC; ++e) xcd_barrier(p0->bar, (volatile LAS unsigned*)&xb_words);
  PH(1, 1, phase_row(p, -1))
  PH(2, REP_GEMM, EpiBf16 E{p->z, ZN_REC}; phase_gemm(p->h, p->WrecT, ZN_REC, E, smem))
  PH(3, REP_SCAN, phase_scan(p, 0, smem))
  PH(4, REP_CHAIN, phase_chain(p, 0, smem))
  PH(5, REP_COMB, phase_combine(p, 0))
  PH(6, REP_GEMM, EpiBf16 E{(bf16_t*)p->oproj, 1024}; phase_gemm(p->r, p->WrecoT, 1024, E, smem); if (gridDim.x > 192) { if (blockIdx.x >= 192) prep_jobs(p, smem, 1, blockIdx.x - 192, gridDim.x - 192); } else prep_jobs(p, smem, 1, blockIdx.x, gridDim.x))
  PH(7, 1, phase_row(p, 0))
  PH(8, REP_GEMM, EpiBf16 E{p->z, ZN_ATT}; phase_gemm(p->h, p->WattT, ZN_ATT, E, smem))
  PH(9, 1, phase_kvprep(p, 0, smem))
  PH(10, REP_ATT, phase_att(p, smem))
  PH(11, REP_GEMM, EpiBf16 E{(bf16_t*)p->oproj, 1024}; phase_gemm(p->r, p->WattoT, 1024, E, smem); if (gridDim.x > 192) { if (blockIdx.x >= 192) prep_jobs(p, smem, 2, blockIdx.x - 192, gridDim.x - 192); } else prep_jobs(p, smem, 2, blockIdx.x, gridDim.x))
  PH(12, 1, phase_row(p, 1))
  PH(13, REP_GEMM, EpiBf16 E{p->z, ZN_REC}; phase_gemm(p->h, p->WrecT + (size_t)ZN_REC * 1024, ZN_REC, E, smem))
  PH(14, REP_SCAN, phase_scan(p, 1, smem))
  PH(15, REP_CHAIN, phase_chain(p, 1, smem))
  PH(16, REP_COMB, phase_combine(p, 1))
  PH(17, REP_GEMM, EpiBf16 E{(bf16_t*)p->oproj, 1024}; phase_gemm(p->r, p->WrecoT + (size_t)1024 * 1024, 1024, E, smem); if (gridDim.x > 192) { if (blockIdx.x >= 192) prep_jobs(p, smem, 3, blockIdx.x - 192, gridDim.x - 192); } else prep_jobs(p, smem, 3, blockIdx.x, gridDim.x))
  PH(18, 1, phase_row(p, 2))
  PH(19, REP_GEMM, EpiBf16 E{p->z, ZN_ATT}; phase_gemm(p->h, p->WattT + (size_t)ZN_ATT * 1024, ZN_ATT, E, smem))
  PH(20, 1, phase_kvprep(p, 1, smem))
  PH(21, REP_ATT, phase_att(p, smem))
  PH(22, REP_GEMM, EpiBf16 E{(bf16_t*)p->oproj, 1024}; phase_gemm(p->r, p->WattoT + (size_t)1024 * 1024, 1024, E, smem))
  PH(23, 1, phase_row(p, 3))
}

extern "C" void kernel_launch(void* const* d_in, const int* in_sizes, int n_in, void* d_out, int out_size, void* d_ws, size_t ws_size, hipStream_t stream) {
  static int grid = 0;
  if (grid == 0) {
    int dev = 0, cus = 0, per_cu = 0;
    hipGetDevice(&dev);
    hipDeviceGetAttribute(&cus, hipDeviceAttributeMultiprocessorCount, dev);
    hipFuncSetAttribute((const void*)mega, hipFuncAttributeMaxDynamicSharedMemorySize, LDS_BYTES);
    hipOccupancyMaxActiveBlocksPerMultiprocessor(&per_cu, (const void*)mega, NTHR, LDS_BYTES);
    if (per_cu < 1) per_cu = 1;
    grid = cus * 1;
    if (grid <= 0) grid = 256;
  }
  Params hp{};
  const float* const* in = (const float* const*)d_in;
  hp.x_prompt = in[0]; hp.x_sample = in[1]; hp.c = in[2]; hp.state = in[3]; hp.cache_k = in[4]; hp.cache_v = in[5]; hp.c_ctx = in[6];
  hp.ada_w = in[7]; hp.ada_b = in[8]; hp.norm_pre = in[9]; hp.norm_post = in[10]; hp.rec_w_in = in[11]; hp.rec_lb = in[12];
  hp.rec_head_norm = in[13]; hp.pool_w = in[14]; hp.pool_scale = in[15]; hp.rec_w_out = in[16]; hp.att_w_in = in[17];
  hp.att_q_norm = in[18]; hp.att_k_norm = in[19]; hp.att_w_out = in[20];
  hp.out = (float*)d_out;
  unsigned char* w = (unsigned char*)d_ws;
  size_t off = 0;
  auto take = [&](size_t bytes) { unsigned char* q = w + off; off += (bytes + 255) & ~(size_t)255; return q; };
  hp.WrecT = (bf16_t*)take((size_t)2 * ZN_REC * 1024 * 2);
  hp.WrecoT = (bf16_t*)take((size_t)2 * 1024 * 1024 * 2);
  hp.WattT = (bf16_t*)take((size_t)2 * ZN_ATT * 1024 * 2);
  hp.WattoT = (bf16_t*)take((size_t)2 * 1024 * 1024 * 2);
  hp.mod = (float*)take((size_t)4 * 9 * 3072 * 4);
  hp.lb = (float*)take(2048 * 4);
  hp.ropec = (float*)take(1024 * 64 * 4);
  hp.ropes = (float*)take(1024 * 64 * 4);
  hp.z = (bf16_t*)take((size_t)NTOK * ZN_REC * 2);
  hp.r = (bf16_t*)take((size_t)NTOK * DM * 2);
  hp.oproj = (float*)take((size_t)NTOK * DM * 4);
  hp.bar = (unsigned*)take(XCD_BAR_WORDS * 4);
  hp.h = (bf16_t*)take((size_t)NTOK * DM * 2);
  hp.Kc = (bf16_t*)take((size_t)16 * 256 * 256 * 2);
  hp.Kl = (bf16_t*)take((size_t)8 * 1536 * 256 * 2);
  hp.Vc = (bf16_t*)take((size_t)16 * 256 * 256 * 2);
  hp.Vl = (bf16_t*)take((size_t)8 * 1536 * 256 * 2);
  {
    const size_t h_off = (size_t)((unsigned char*)hp.h - w);
    const size_t need = h_off + (size_t)(3072 - 877) * 28672;
    if (off < need) off = need;
  }
  if (off > ws_size) { fprintf(stderr, "workspace too small: need %zu have %zu\n", off, ws_size); return; }
  (void)hipMemsetAsync(hp.bar, 0, XCD_BAR_WORDS * 4, stream);
#if MULTI_LAUNCH
  for (int ph = 0; ph < NPHASE; ++ph) {
    hp.ph_lo = ph; hp.ph_hi = ph + 1; hp.coop = 0;
    hipLaunchKernelGGL(mega, dim3(grid), dim3(NTHR), LDS_BYTES, stream, hp);
  }
#else
  hp.ph_lo = 0; hp.ph_hi = NPHASE; hp.coop = 1;
  void* args[] = {&hp};
  hipError_t e = hipLaunchCooperativeKernel((const void*)mega, dim3(grid), dim3(NTHR), args, LDS_BYTES, stream);
  if (e != hipSuccess) fprintf(stderr, "cooperative launch failed: %s (grid %d)\n", hipGetErrorString(e), grid);
#endif
}
```
